# Optimizing an MI355X kernel written in HIP

```python
import jax, jax.numpy as jnp
from jax import lax
import numpy as np

D_MODEL = 1024
BATCH = 16
SEQ = 256
DEPTH = 2
DEC_BATCH = 4
DEC_SEQ = 4096
PAST_LEN = 256

GRID_W = 64
D_MIX = D_MODEL
HEAD_DIM = 64
A_HEADS = D_MIX // 128
A_KV_HEADS = A_HEADS // 4
A_GROUP = A_HEADS // A_KV_HEADS
A_WIDTH = A_HEADS * HEAD_DIM
A_KV_WIDTH = A_KV_HEADS * HEAD_DIM
WINDOW = 128
BLOCK = 128
B_WIDTH = D_MIX // 4
B_GROUP_DIM = 64
B_GROUPS = B_WIDTH // B_GROUP_DIM
C_HEADS = D_MIX // 256
C_NOPE = 64
C_ROPE = 32
C_V = 64
C_Q_LORA = 192
C_KV_LORA = 128
C_WIDTH = C_HEADS * C_V
IN_COLS = A_WIDTH + 2 * A_KV_WIDTH + B_WIDTH + C_Q_LORA + C_KV_LORA + C_ROPE
D_FF = 2816
CONV_W = 3
ROPE_BASE = 10000.0
EPS = 1e-6
NEG = -1e30

kernel_name = "hybrid_diffusion_parallel_heads_step"


def _rms_norm(x, g):
    xf = x.astype(jnp.float32)
    y = xf * lax.rsqrt(jnp.mean(xf * xf, axis=-1, keepdims=True) + EPS)
    return (y * g.astype(jnp.float32)).astype(x.dtype)


def _modulation(cvec, w_ada, b_ada):
    m = jax.nn.silu(cvec) @ w_ada + b_ada
    return jnp.split(m[:, None, :], 6, axis=-1)


def _axial_tables(n_tok, dim):
    rows = n_tok // GRID_W
    r = jnp.repeat(jnp.arange(rows), GRID_W).astype(jnp.float32)
    col = jnp.tile(jnp.arange(GRID_W), rows).astype(jnp.float32)
    quarter = dim // 4
    inv = ROPE_BASE ** (-jnp.arange(quarter, dtype=jnp.float32) / quarter)
    ang_r = r[:, None] * inv
    ang_c = col[:, None] * inv
    return (jnp.cos(ang_r), jnp.sin(ang_r), jnp.cos(ang_c), jnp.sin(ang_c))


def _rot(x, cos, sin):
    x1, x2 = jnp.split(x, 2, axis=-1)
    return jnp.concatenate([x1 * cos - x2 * sin, x2 * cos + x1 * sin], axis=-1)


def _apply_axial_rope(x, tables):
    cr, sr, cc, sc = [t.astype(x.dtype)[:, None, :] for t in tables]
    half = x.shape[-1] // 2
    return jnp.concatenate([_rot(x[..., :half], cr, sr), _rot(x[..., half:], cc, sc)], axis=-1)


def _split_proj(p):
    sizes = [A_WIDTH, A_KV_WIDTH, A_KV_WIDTH, B_WIDTH, C_Q_LORA, C_KV_LORA, C_ROPE]
    idx = np.cumsum(sizes)[:-1].tolist()
    return jnp.split(p, idx, axis=-1)


def _sink_softmax(logits, sink_b):
    p = jax.nn.softmax(jnp.concatenate([logits, sink_b], axis=-1), axis=-1)
    return p[..., :-1]


def _ctx_attn_a(q, k, v, sink):
    B, n = q.shape[:2]
    qg = q.reshape(B, n, A_KV_HEADS, A_GROUP, HEAD_DIM)
    s = jnp.einsum('bqhgd,bkhd->bhgqk', qg, k, preferred_element_type=jnp.float32) * (HEAD_DIM ** -0.5)
    sink_b = jnp.broadcast_to(sink.astype(jnp.float32).reshape(1, A_KV_HEADS, A_GROUP, 1, 1), s.shape[:-1] + (1,))
    p = _sink_softmax(s, sink_b)
    out = jnp.einsum('bhgqk,bkhd->bqhgd', p.astype(v.dtype), v)
    return out.reshape(B, n, A_WIDTH)


def _latent_attn_a(q, k, v, k_ctx, v_ctx, sink):
    B, n = q.shape[:2]
    nb = n // BLOCK
    qb = q.reshape(B, nb, BLOCK, A_KV_HEADS, A_GROUP, HEAD_DIM)
    pad = ((0, 0), (BLOCK, BLOCK), (0, 0), (0, 0))
    kp = jnp.pad(k, pad).reshape(B, nb + 2, BLOCK, A_KV_HEADS, HEAD_DIM)
    vp = jnp.pad(v, pad).reshape(B, nb + 2, BLOCK, A_KV_HEADS, HEAD_DIM)
    kband = jnp.concatenate([kp[:, :-2], kp[:, 1:-1], kp[:, 2:]], axis=2)
    vband = jnp.concatenate([vp[:, :-2], vp[:, 1:-1], vp[:, 2:]], axis=2)
    scale = HEAD_DIM ** -0.5
    s_band = jnp.einsum('bnqhgd,bnkhd->bnhgqk', qb, kband, preferred_element_type=jnp.float32) * scale
    qi = jnp.arange(BLOCK)
    kj = jnp.arange(3 * BLOCK)
    rel = qi[:, None] - kj[None, :] + BLOCK
    key_pos = (jnp.arange(nb)[:, None] - 1) * BLOCK + kj[None, :]
    in_range = (key_pos >= 0) & (key_pos < n)
    mask = (jnp.abs(rel) <= WINDOW)[None] & in_range[:, None, :]
    s_band = jnp.where(mask[None, :, None, None], s_band, NEG)
    s_ctx = jnp.einsum('bnqhgd,bchd->bnhgqc', qb, k_ctx, preferred_element_type=jnp.float32) * scale
    sink_b = jnp.broadcast_to(sink.astype(jnp.float32).reshape(1, 1, A_KV_HEADS, A_GROUP, 1, 1), s_band.shape[:-1] + (1,))
    p = _sink_softmax(jnp.concatenate([s_band, s_ctx], axis=-1), sink_b)
    p_band = p[..., :3 * BLOCK].astype(v.dtype)
    p_ctx = p[..., 3 * BLOCK:].astype(v.dtype)
    out = (jnp.einsum('bnhgqk,bnkhd->bnqhgd', p_band, vband)
           + jnp.einsum('bnhgqc,bchd->bnqhgd', p_ctx, v_ctx))
    return out.reshape(B, n, A_WIDTH)


def _fourier_mix(f):
    B, n, _ = f.shape
    fg = f.reshape(B, n, B_GROUPS, B_GROUP_DIM).astype(jnp.float32)
    y = jnp.fft.fft2(fg, axes=(1, 3), norm='ortho').real
    return y.reshape(B, n, B_WIDTH).astype(f.dtype)


def _mla_q(cq, g_cq, w_uq):
    B, n = cq.shape[:2]
    q = (_rms_norm(cq, g_cq) @ w_uq).reshape(B, n, C_HEADS, C_NOPE + C_ROPE)
    return q[..., :C_NOPE], q[..., C_NOPE:]


def _mla_kv(ckv_n, kr, w_ukv):
    B, n = ckv_n.shape[:2]
    kv = (ckv_n @ w_ukv).reshape(B, n, C_HEADS, C_NOPE + C_V)
    k = jnp.concatenate([kv[..., :C_NOPE], jnp.broadcast_to(kr[:, :, None, :], (B, n, C_HEADS, C_ROPE))], axis=-1)
    return k, kv[..., C_NOPE:]


def _ctx_mla(q, k, v):
    B, n = q.shape[:2]
    s = jnp.einsum('bqhd,bkhd->bhqk', q, k, preferred_element_type=jnp.float32) * ((C_NOPE + C_ROPE) ** -0.5)
    p = jax.nn.softmax(s, axis=-1).astype(v.dtype)
    return jnp.einsum('bhqk,bkhd->bqhd', p, v).reshape(B, n, C_WIDTH)


def _latent_mla(q, k, v, k_ctx, v_ctx):
    B, n = q.shape[:2]
    nb = n // BLOCK
    scale = (C_NOPE + C_ROPE) ** -0.5
    qblocks = q.reshape(B, nb, BLOCK, C_HEADS, C_NOPE + C_ROPE).transpose(1, 0, 2, 3, 4)

    def one_block(qb):
        s_lat = jnp.einsum('bqhd,bkhd->bhqk', qb, k, preferred_element_type=jnp.float32)
        s_ctx = jnp.einsum('bqhd,bkhd->bhqk', qb, k_ctx, preferred_element_type=jnp.float32)
        p = jax.nn.softmax(jnp.concatenate([s_lat, s_ctx], axis=-1) * scale, axis=-1).astype(v.dtype)
        return (jnp.einsum('bhqk,bkhd->bqhd', p[..., :n], v)
                + jnp.einsum('bhqk,bkhd->bqhd', p[..., n:], v_ctx))

    out = lax.map(one_block, qblocks)
    return out.transpose(1, 0, 2, 3, 4).reshape(B, n, C_WIDTH)


def _mixer_context(h, w_in, sink, g_cq, w_uq, g_ckv, w_ukv):
    B, n, _ = h.shape
    qa, ka, va, fb, cq, ckv, kr = _split_proj(h @ w_in)
    qa = qa.reshape(B, n, A_HEADS, HEAD_DIM)
    ka = ka.reshape(B, n, A_KV_HEADS, HEAD_DIM)
    va = va.reshape(B, n, A_KV_HEADS, HEAD_DIM)
    out_a = _ctx_attn_a(qa, ka, va, sink)
    out_b = _fourier_mix(fb)
    ckv_n = _rms_norm(ckv, g_ckv)
    q_nope, q_rope = _mla_q(cq, g_cq, w_uq)
    kc, vc = _mla_kv(ckv_n, kr, w_ukv)
    out_c = _ctx_mla(jnp.concatenate([q_nope, q_rope], axis=-1), kc, vc)
    return jnp.concatenate([out_a, out_b, out_c], axis=-1), ka, va, ckv_n, kr


def _mixer_latent(h, k_ctx_a, v_ctx_a, ckv_ctx, kr_ctx, w_in, sink, g_cq, w_uq, g_ckv, w_ukv):
    B, n, _ = h.shape
    qa, ka, va, fb, cq, ckv, kr = _split_proj(h @ w_in)
    tab_a = _axial_tables(n, HEAD_DIM)
    tab_c = _axial_tables(n, C_ROPE)
    qa = _apply_axial_rope(qa.reshape(B, n, A_HEADS, HEAD_DIM), tab_a)
    ka = _apply_axial_rope(ka.reshape(B, n, A_KV_HEADS, HEAD_DIM), tab_a)
    va = va.reshape(B, n, A_KV_HEADS, HEAD_DIM)
    out_a = _latent_attn_a(qa, ka, va, k_ctx_a, v_ctx_a, sink)
    out_b = _fourier_mix(fb)
    ckv_n = _rms_norm(ckv, g_ckv)
    q_nope, q_rope = _mla_q(cq, g_cq, w_uq)
    q_rope = _apply_axial_rope(q_rope, tab_c)
    kr = _apply_axial_rope(kr[:, :, None, :], tab_c)[:, :, 0]
    kc, vc = _mla_kv(ckv_n, kr, w_ukv)
    kc_ctx, vc_ctx = _mla_kv(ckv_ctx, kr_ctx, w_ukv)
    out_c = _latent_mla(jnp.concatenate([q_nope, q_rope], axis=-1), kc, vc, kc_ctx, vc_ctx)
    return jnp.concatenate([out_a, out_b, out_c], axis=-1)


def _conv_ffn(h, w_ug, conv_w, conv_b, w_down):
    n = h.shape[1]
    u = h @ w_ug
    half = CONV_W // 2
    up = jnp.pad(u, ((0, 0), (half, half), (0, 0)))
    uc = sum(up[:, i:i + n] * conv_w[i] for i in range(CONV_W)) + conv_b
    a, g = jnp.split(uc, 2, axis=-1)
    return (jax.nn.silu(g) * a) @ w_down


def setup_inputs(seed: int = 0) -> dict:
    key = jax.random.key(seed)
    ks = jax.random.split(key, 26)
    f32 = jnp.float32

    def nrm(k, shape, scale):
        return jax.random.normal(k, shape, f32) * scale

    return {
        "x_prompt": nrm(ks[0], (BATCH, SEQ, D_MODEL), 1.0),
        "x_sample": nrm(ks[1], (DEC_BATCH, DEC_SEQ, D_MODEL), 1.0),
        "cache_win_k": nrm(ks[2], (DEC_BATCH, DEPTH, PAST_LEN, A_KV_HEADS, HEAD_DIM), 1.0),
        "cache_win_v": nrm(ks[3], (DEC_BATCH, DEPTH, PAST_LEN, A_KV_HEADS, HEAD_DIM), 1.0),
        "cache_mla_ckv": nrm(ks[4], (DEC_BATCH, DEPTH, PAST_LEN, C_KV_LORA), 1.0),
        "cache_mla_krope": nrm(ks[5], (DEC_BATCH, DEPTH, PAST_LEN, C_ROPE), 1.0),
        "c": nrm(ks[6], (DEC_BATCH, D_MODEL), 1.0),
        "c_ctx": nrm(ks[7], (D_MODEL,), 1.0),
        "w_ada": nrm(ks[8], (DEPTH, D_MODEL, 6 * D_MODEL), 0.5 * D_MODEL ** -0.5),
        "b_ada": nrm(ks[9], (DEPTH, 6 * D_MODEL), 0.02),
        "g_mix": 1.0 + nrm(ks[10], (DEPTH, D_MODEL), 0.05),
        "w_in": nrm(ks[11], (DEPTH, D_MODEL, IN_COLS), D_MODEL ** -0.5),
        "sink": nrm(ks[12], (DEPTH, A_HEADS), 0.5),
        "g_cq": 1.0 + nrm(ks[13], (DEPTH, C_Q_LORA), 0.05),
        "w_uq": nrm(ks[14], (DEPTH, C_Q_LORA, C_HEADS * (C_NOPE + C_ROPE)), C_Q_LORA ** -0.5),
        "g_ckv": 1.0 + nrm(ks[15], (DEPTH, C_KV_LORA), 0.05),
        "w_ukv": nrm(ks[16], (DEPTH, C_KV_LORA, C_HEADS * (C_NOPE + C_V)), C_KV_LORA ** -0.5),
        "w_out": nrm(ks[17], (DEPTH, D_MIX, D_MODEL), D_MIX ** -0.5),
        "g_ffn": 1.0 + nrm(ks[18], (DEPTH, D_MODEL), 0.05),
        "w_ug": nrm(ks[19], (DEPTH, D_MODEL, 2 * D_FF), D_MODEL ** -0.5),
        "conv_w": nrm(ks[20], (DEPTH, CONV_W, 2 * D_FF), CONV_W ** -0.5),
        "conv_b": nrm(ks[21], (DEPTH, 2 * D_FF), 0.02),
        "w_down": nrm(ks[22], (DEPTH, D_FF, D_MODEL), D_FF ** -0.5),
        "g_final": 1.0 + nrm(ks[23], (D_MODEL,), 0.05),
    }


def reference(x_prompt, x_sample, cache_win_k, cache_win_v, cache_mla_ckv, cache_mla_krope,
              c, c_ctx, w_ada, b_ada, g_mix, w_in, sink, g_cq, w_uq, g_ckv, w_ukv, w_out,
              g_ffn, w_ug, conv_w, conv_b, w_down, g_final):
    xp = x_prompt
    xs = x_sample
    new_k, new_v, new_ckv, new_kr = [], [], [], []
    for l in range(DEPTH):
        sh1, sc1, gt1, sh2, sc2, gt2 = _modulation(c_ctx[None, :], w_ada[l], b_ada[l])
        h = _rms_norm(xp, g_mix[l]) * (1.0 + sc1) + sh1
        mix, ka, va, ckv_n, kr = _mixer_context(h, w_in[l], sink[l], g_cq[l], w_uq[l], g_ckv[l], w_ukv[l])
        xp = xp + gt1 * (mix @ w_out[l])
        h = _rms_norm(xp, g_ffn[l]) * (1.0 + sc2) + sh2
        xp = xp + gt2 * _conv_ffn(h, w_ug[l], conv_w[l], conv_b[l], w_down[l])
        new_k.append(ka)
        new_v.append(va)
        new_ckv.append(ckv_n)
        new_kr.append(kr)
        sh1, sc1, gt1, sh2, sc2, gt2 = _modulation(c, w_ada[l], b_ada[l])
        h = _rms_norm(xs, g_mix[l]) * (1.0 + sc1) + sh1
        mix = _mixer_latent(h, cache_win_k[:, l], cache_win_v[:, l], cache_mla_ckv[:, l], cache_mla_krope[:, l],
                            w_in[l], sink[l], g_cq[l], w_uq[l], g_ckv[l], w_ukv[l])
        xs = xs + gt1 * (mix @ w_out[l])
        h = _rms_norm(xs, g_ffn[l]) * (1.0 + sc2) + sh2
        xs = xs + gt2 * _conv_ffn(h, w_ug[l], conv_w[l], conv_b[l], w_down[l])
    y_prompt = _rms_norm(xp, g_final)
    y_sample = _rms_norm(xs, g_final)
    state_win_k = jnp.stack(new_k, axis=1)
    state_win_v = jnp.stack(new_v, axis=1)
    state_mla_ckv = jnp.stack(new_ckv, axis=1)
    state_mla_krope = jnp.stack(new_kr, axis=1)
    return (y_prompt, y_sample, state_win_k, state_win_v, state_mla_ckv, state_mla_krope)
```

```cpp
#include <hip/hip_runtime.h>
#include <hip/hip_cooperative_groups.h>
#include <cstdio>
#include <cstdint>
namespace cg = cooperative_groups;

#define LAS __attribute__((address_space(3)))
typedef unsigned short bf16_t;
typedef short bf16x8 __attribute__((ext_vector_type(8)));
typedef short s16x4 __attribute__((ext_vector_type(4)));
typedef float f32x4 __attribute__((ext_vector_type(4)));
typedef float f32x16 __attribute__((ext_vector_type(16)));
typedef unsigned u32x4 __attribute__((ext_vector_type(4)));
typedef unsigned u32x2 __attribute__((ext_vector_type(2)));

constexpr int NTOK = 20480, NCTX = 4096, TOKP = 21504, DM = 1024, NPROJ = 1536, DFF = 2816, MIXW = 1280;
constexpr float EPSN = 1e-6f;
constexpr float LOG2E = 1.4426950408889634f;
constexpr float QS_A = 0.125f * LOG2E;
constexpr float QS_C = 0.10206207261596575f * LOG2E;
constexpr size_t OUT_K = (size_t)NTOK * DM, OUT_V = OUT_K + 1048576, OUT_CKV = OUT_V + 1048576, OUT_KR = OUT_CKV + 1048576;
constexpr size_t MiB = 1u << 20;
constexpr size_t WS_W = 1 * MiB, W_LSTRIDE = 22 * MiB + 512 * 1024;
constexpr size_t WO_IN = 0, WO_OUT = 3 * MiB, WO_UG = 5 * MiB + 512 * 1024, WO_DN = 16 * MiB + 512 * 1024, WO_UQ = 22 * MiB, WO_WK = 22 * MiB + 256 * 1024, WO_WV = 22 * MiB + 320 * 1024;
constexpr size_t WS_MOD = 46 * MiB, WS_TAB = 46 * MiB + 256 * 1024, WS_DFT256 = 46 * MiB + 512 * 1024;
constexpr size_t WS_H = 47 * MiB;
constexpr size_t WS_R = 97 * MiB;
constexpr size_t WS_PROJ = WS_R, WS_DFT = WS_R;
constexpr size_t WS_QA = 161 * MiB, WS_KA = 181 * MiB, WS_CQN = 186 * MiB + 256 * 1024, WS_CKVN = 196 * MiB + 256 * 1024;
constexpr size_t WS_QC = 201 * MiB + 512 * 1024, WS_KC = 216 * MiB + 512 * 1024, WS_VT = 227 * MiB, WS_KR = 237 * MiB + 512 * 1024, WS_XT = 239 * MiB;
constexpr size_t WS_ACT = WS_R, WS_EDGE = 207 * MiB;
constexpr size_t WS_XE = 129 * MiB, WS_XO = 133 * MiB, WS_XH = 137 * MiB;
constexpr size_t T_COSA = 0, T_SINA = 4096, T_COSC = 8192, T_SINC = 10240, T_TABC = 12288, T_TABS = 20480;
constexpr int RING_BYTES = 131072, E_OFF = RING_BYTES + 1024, LDS_BYTES = 147456;

typedef float f32x2_t __attribute__((ext_vector_type(2))); typedef __bf16 bf16x2_t __attribute__((ext_vector_type(2)));
__device__ __forceinline__ unsigned cvt_pk_bf16(float lo, float hi) { f32x2_t v = {lo, hi}; bf16x2_t b = __builtin_convertvector(v, bf16x2_t); return __builtin_bit_cast(unsigned, b); }
__device__ __forceinline__ bf16_t f2bf(float f) { return (bf16_t)(cvt_pk_bf16(f, 0.f) & 0xffffu); }
__device__ __forceinline__ float bf2f(bf16_t b) { return __uint_as_float((unsigned)b << 16); }
__device__ __forceinline__ float wave_sum(float v) {
#pragma unroll
    for (int o = 1; o < 64; o <<= 1) v += __shfl_xor(v, o);
    return v;
}
#define LDS_WAIT() asm volatile("s_waitcnt lgkmcnt(0)" ::: "memory")
#define GAS __attribute__((address_space(1)))
template <class T> __device__ __forceinline__ T gld(const void* p) { return *(const GAS T*)p; }
template <class T> __device__ __forceinline__ void gst(void* p, T v) { *(GAS T*)p = v; }

namespace pg8 {
constexpr int BM = 256, BK = 64, HALF = 128, HTB = HALF * BK * 2, STAGE_BYTES = 8 * HTB, NXCD = 8, WGM = 8;
__host__ __device__ __forceinline__ int lds_byte(int r, int c) { const int st = (r >> 4) * 2 + (c >> 5), rr = r & 15, cc = c & 31, ob = rr * 64 + cc * 2; return st * 1024 + (ob ^ (((ob >> 9) & 1) << 5)); }
__host__ __device__ __forceinline__ void stage_rc(int b, int& R, int& C) { const int st = b / 1024, sb = b % 1024, swz = sb ^ (((sb >> 9) & 1) << 5); R = (st >> 1) * 16 + swz / 64; C = (st & 1) * 32 + (swz % 64) / 2; }
__host__ __device__ __forceinline__ int perm32(int rho) { const int n = rho >> 4, i = rho & 15; return 8 * (i >> 2) + 4 * n + (i & 3); }
struct Unit { int pm, pn, kt0, nt, part; };
struct Gemm { const bf16_t* A; const bf16_t* Bt; int lda, ldb, K; unsigned tsA, tsB; };
struct StaticOrder {
    int nM, nN, nwg, G, c, ntk;
    __device__ void init(int nM_, int nN_, int G_, int c_, int ntk_) { nM = nM_; nN = nN_; nwg = nM * nN; G = G_; c = c_; ntk = ntk_; }
    __device__ bool next(int i, Unit& u) const {
        const long L = (long)i * G + c; if (L >= nwg) return false;
        int wgid = (int)L; { const int q = nwg / NXCD, r = nwg % NXCD, xcd = wgid % NXCD, off = wgid / NXCD; wgid = (xcd < r ? xcd * (q + 1) : r * (q + 1) + (xcd - r) * q) + off; }
        const int nig = WGM * nN, gid = wgid / nig, fm = gid * WGM, gsz = (nM - fm) < WGM ? (nM - fm) : WGM;
        u.pm = fm + ((wgid % nig) % gsz); u.pn = (wgid % nig) / gsz; u.kt0 = 0; u.nt = ntk; u.part = -1; return true;
    }
};
struct SplitOrder { int vcu, ntk, a;
    __device__ bool next(int i, Unit& u) const {
        if (i == 0) { u.pm = vcu >> 2; u.pn = vcu & 3; u.kt0 = 0; u.nt = ntk; u.part = -1; return true; }
        if (i == 1) { const int u64 = vcu >> 2, part = vcu & 3; u.pm = 64 + (u64 >> 2); u.pn = u64 & 3;
            const int over = part > 2 ? part - 2 : 0;
            u.kt0 = a * part - 2 * over; u.nt = part < 2 ? a : a - 2; u.part = part; return true; }
        return false; } };
struct OneUnit { int has, pm, pn, ntk; __device__ bool next(int i, Unit& u) const { if (i > 0 || !has) return false; u.pm = pm; u.pn = pn; u.kt0 = 0; u.nt = ntk; u.part = -1; return true; } };

template <bool SPLIT = false, class Epi, class Sched>
__device__ __forceinline__ void gemm_phase(LAS unsigned char* lds, const Gemm g, const Sched& S, const Epi& E) {
    int tid_ = threadIdx.x; asm volatile("" : "+v"(tid_));
    const int tid = tid_, wid = __builtin_amdgcn_readfirstlane(tid >> 6), lane = tid & 63, wr = wid >> 2, wc = wid & 3, fr = lane & 15, fq = lane >> 4;
    unsigned voffA[2], voffB[2];
#pragma unroll
    for (int i = 0; i < 2; ++i) { int R, C; stage_rc(tid * 16 + i * 8192, R, C); const int Rb = Epi::PERM ? ((R & ~31) + perm32(R & 31)) : R;
        voffA[i] = (unsigned)(R * g.lda + C) * 2u; voffB[i] = (unsigned)(Rb * g.ldb + C) * 2u; }
    const size_t kstep = (size_t)(BK * 2);
    const size_t hstepA = (size_t)HALF * g.lda * 2, hstepB = (size_t)HALF * g.ldb * 2;
    const unsigned ldsw = (unsigned)wid * 1024u;
    const int aoff = lds_byte(wr * 64 + fr, fq * 8), boff = lds_byte(wc * 32 + fr, fq * 8);
#define PG8_SA(b, h) (((b) * 2 + (h)) * HTB)
#define PG8_SB(b, h) ((4 + (b) * 2 + (h)) * HTB)
#define PG8_STAGE(bufoff, gbase, voff) do { _Pragma("unroll") for (int _i = 0; _i < 2; ++_i) \
        __builtin_amdgcn_global_load_lds((const unsigned*)((const char*)(gbase) + (voff)[_i]), (LAS unsigned*)(lds + (bufoff) + ldsw + _i * 8192), 16, 0, 0); } while (0)
#define PG8_LDA(dst, b, h) do { _Pragma("unroll") for (int m = 0; m < 4; ++m) _Pragma("unroll") for (int k = 0; k < 2; ++k) dst[m][k] = *(const LAS bf16x8*)(lds + PG8_SA(b, h) + aoff + m * 2048 + k * 1024); } while (0)
#define PG8_LDB(dst, b, h) do { _Pragma("unroll") for (int n = 0; n < 2; ++n) _Pragma("unroll") for (int k = 0; k < 2; ++k) dst[n][k] = *(const LAS bf16x8*)(lds + PG8_SB(b, h) + boff + n * 2048 + k * 1024); } while (0)
#define PG8_MMA(ai, bj, At, Bt) do { __builtin_amdgcn_s_setprio(1); _Pragma("unroll") for (int m = 0; m < 4; ++m) _Pragma("unroll") for (int n = 0; n < 2; ++n) _Pragma("unroll") for (int k = 0; k < 2; ++k) \
        acc[ai][bj][m][n] = __builtin_amdgcn_mfma_f32_16x16x32_bf16(Bt[n][k], At[m][k], acc[ai][bj][m][n], 0, 0, 0); __builtin_amdgcn_s_setprio(0); } while (0)
#define PG8_WAIT_V(n) asm volatile("s_waitcnt vmcnt(" #n ")" ::: "memory")
#define PG8_WAIT_L(n) asm volatile("s_waitcnt lgkmcnt(" #n ")" ::: "memory")
#define PG8_BAR __builtin_amdgcn_s_barrier()
#define PG8_SCHED __builtin_amdgcn_sched_barrier(0)
    Unit cur, nxt; int ui = 0;
    if (!S.next(0, cur)) return;
    f32x4 acc[2][2][4][2];
#pragma unroll
    for (int a = 0; a < 2; ++a)
#pragma unroll
        for (int b = 0; b < 2; ++b)
#pragma unroll
            for (int m = 0; m < 4; ++m)
#pragma unroll
                for (int n = 0; n < 2; ++n) acc[a][b][m][n] = (f32x4){0.f, 0.f, 0.f, 0.f};
    bf16x8 At[4][2], B0[2][2], B1[2][2];
    const char* cA = (const char*)g.A + (size_t)cur.pm * g.tsA + (SPLIT ? (size_t)cur.kt0 * 128 : 0); const char* cB = (const char*)g.Bt + (size_t)cur.pn * g.tsB + (SPLIT ? (size_t)cur.kt0 * 128 : 0);
    const int ntk = g.K / BK;
    PG8_STAGE(PG8_SB(0, 0), cB, voffB); PG8_STAGE(PG8_SB(0, 1), cB + hstepB, voffB); PG8_STAGE(PG8_SA(0, 0), cA, voffA); PG8_STAGE(PG8_SA(0, 1), cA + hstepA, voffA);
    if (wr == 1) PG8_BAR;
    PG8_WAIT_V(2); PG8_BAR;
    PG8_STAGE(PG8_SB(1, 0), cB + kstep, voffB); PG8_STAGE(PG8_SA(1, 0), cA + kstep, voffA); PG8_STAGE(PG8_SB(1, 1), cB + hstepB + kstep, voffB);
    PG8_WAIT_V(6); PG8_BAR;
    for (;;) {
        const bool has_next = S.next(ui + 1, nxt);
        const char* nA = has_next ? (const char*)g.A + (size_t)nxt.pm * g.tsA + (SPLIT ? (size_t)nxt.kt0 * 128 : 0) : cA; const char* nB = has_next ? (const char*)g.Bt + (size_t)nxt.pn * g.tsB + (SPLIT ? (size_t)nxt.kt0 * 128 : 0) : cB;
        const int nt = SPLIT ? cur.nt : ntk;
        for (int t = 0; t < nt; t += 2) {
            const bool last = (t == nt - 2);
            const char* a1 = cA + (size_t)(t + 1) * kstep;
            const char* a2 = last ? nA : cA + (size_t)(t + 2) * kstep; const char* b2 = last ? nB : cB + (size_t)(t + 2) * kstep;
            const char* a3 = a2 + kstep; const char* b3 = b2 + kstep;
            PG8_LDB(B0, 0, 0); PG8_LDB(B1, 0, 1); PG8_SCHED; PG8_LDA(At, 0, 0); PG8_STAGE(PG8_SA(1, 1), a1 + hstepA, voffA);
            PG8_WAIT_V(8); PG8_WAIT_L(0); PG8_BAR; PG8_MMA(0, 0, At, B0); PG8_MMA(0, 1, At, B1); PG8_BAR; PG8_SCHED;
            PG8_LDA(At, 0, 1); PG8_STAGE(PG8_SB(0, 0), b2, voffB); PG8_STAGE(PG8_SB(0, 1), b2 + hstepB, voffB); PG8_STAGE(PG8_SA(0, 0), a2, voffA);
            PG8_WAIT_V(8); PG8_WAIT_L(0); PG8_BAR; PG8_MMA(1, 0, At, B0); PG8_MMA(1, 1, At, B1); PG8_BAR; PG8_SCHED;
            PG8_LDB(B0, 1, 0); PG8_LDB(B1, 1, 1); PG8_SCHED; PG8_LDA(At, 1, 0); PG8_STAGE(PG8_SA(0, 1), a2 + hstepA, voffA);
            PG8_WAIT_V(8); PG8_WAIT_L(0); PG8_BAR; PG8_MMA(0, 0, At, B0); PG8_MMA(0, 1, At, B1); PG8_BAR; PG8_SCHED;
            PG8_LDA(At, 1, 1); PG8_STAGE(PG8_SB(1, 0), b3, voffB); PG8_STAGE(PG8_SB(1, 1), b3 + hstepB, voffB); PG8_STAGE(PG8_SA(1, 0), a3, voffA);
            PG8_WAIT_V(8); PG8_WAIT_L(0); PG8_BAR; PG8_MMA(1, 0, At, B0); PG8_MMA(1, 1, At, B1); PG8_BAR; PG8_SCHED;
        }
        if (wr == 0) PG8_BAR;
        E(acc, cur, wr, wc, fr, fq, lds);
        if (!has_next) break;
#pragma unroll
        for (int a = 0; a < 2; ++a)
#pragma unroll
            for (int b = 0; b < 2; ++b)
#pragma unroll
                for (int m = 0; m < 4; ++m)
#pragma unroll
                    for (int n = 0; n < 2; ++n) acc[a][b][m][n] = (f32x4){0.f, 0.f, 0.f, 0.f};
        cur = nxt; cA = nA; cB = nB; ++ui;
        if (wr == 1) PG8_BAR;
    }
    PG8_WAIT_V(0);
    PG8_BAR;
#undef PG8_SA
#undef PG8_SB
#undef PG8_STAGE
#undef PG8_LDA
#undef PG8_LDB
#undef PG8_MMA
#undef PG8_WAIT_V
#undef PG8_WAIT_L
#undef PG8_BAR
#undef PG8_SCHED
}

struct EpiStore {
    static constexpr bool PERM = true;
    bf16_t* O; int ldc; int ncols; float scale;
    __device__ __forceinline__ void operator()(const f32x4 (&acc)[2][2][4][2], const Unit& u, int wr, int wc, int fr_, int fq_, LAS unsigned char*) const {
        int fr = fr_, fq = fq_; asm volatile("" : "+v"(fr), "+v"(fq));
        const int row0 = u.pm * BM + wr * 64 + fr, col0 = u.pn * BM + wc * 32 + 8 * fq;
#pragma unroll
        for (int ai = 0; ai < 2; ++ai)
#pragma unroll
            for (int m = 0; m < 4; ++m) { bf16_t* rowp = O + (size_t)(row0 + ai * HALF + m * 16) * ldc + col0;
#pragma unroll
                for (int bj = 0; bj < 2; ++bj) if (col0 + bj * HALF < ncols) { const f32x4 v0 = acc[ai][bj][m][0] * scale, v1 = acc[ai][bj][m][1] * scale;
                    u32x4 w; w.x = cvt_pk_bf16(v0[0], v0[1]); w.y = cvt_pk_bf16(v0[2], v0[3]); w.z = cvt_pk_bf16(v1[0], v1[1]); w.w = cvt_pk_bf16(v1[2], v1[3]);
                    gst<u32x4>(rowp + bj * HALF, w); } }
    }
};
struct EpiResid {
    static constexpr bool PERM = false;
    const float* xin0; const float* xin1; float* out; const float* gate; float* partA; float* partB;
    __device__ __forceinline__ void operator()(const f32x4 (&acc)[2][2][4][2], const Unit& u, int wr, int wc, int fr_, int fq_, LAS unsigned char*) const {
        int fr = fr_, fq = fq_; asm volatile("" : "+v"(fr), "+v"(fq));
        const int mi = u.pm < 16 ? 0 : 1 + ((u.pm - 16) >> 4);
        const float* gp = gate + mi * 6144;
        const float* xb = u.pm < 16 ? xin0 : xin1 - (size_t)NCTX * DM;
        const int row0 = u.pm * BM + wr * 64 + fr, col0 = u.pn * BM + wc * 32 + 4 * fq;
#pragma unroll
        for (int bj = 0; bj < 2; ++bj)
#pragma unroll
            for (int n = 0; n < 2; ++n) { const f32x4 gv = gld<f32x4>(gp + col0 + bj * HALF + n * 16);
#pragma unroll
                for (int ai = 0; ai < 2; ++ai)
#pragma unroll
                    for (int m = 0; m < 4; ++m) { const size_t off = (size_t)(row0 + ai * HALF + m * 16) * DM + col0 + bj * HALF + n * 16;
                        if (u.part < 0) { const f32x4 o = gld<f32x4>(xb + off) + gv * acc[ai][bj][m][n]; gst<f32x4>(out + off, o); }
                        else { bf16_t* pp = (u.part < 3 ? (bf16_t*)partA + (size_t)u.part * 4194304 : (bf16_t*)partB) + (off - (size_t)16384 * DM); const f32x4 a_ = acc[ai][bj][m][n];
                            gst<u32x2>(pp, (u32x2){cvt_pk_bf16(a_[0], a_[1]), cvt_pk_bf16(a_[2], a_[3])}); } } }
    }
};
struct EpiF1 {
    static constexpr bool PERM = true;
    bf16_t* MIXp; int ctx; float scale; const float* xh;
    __device__ __forceinline__ void operator()(const f32x4 (&acc)[2][2][4][2], const Unit& u, int wr, int wc, int fr_, int fq_, LAS unsigned char*) const {
        int fr = fr_, fq = fq_; asm volatile("" : "+v"(fr), "+v"(fq));
        int cs, tokbase;
        if (ctx) { cs = u.pm; tokbase = 256 * u.pn; } else { cs = u.pm >> 4; tokbase = NCTX + 4096 * u.pn + (u.pm & 15) * 256; }
#pragma unroll
        for (int ai = 0; ai < 2; ++ai)
#pragma unroll
            for (int m = 0; m < 4; ++m) { const int rowl = wr * 64 + fr + ai * HALF + m * 16;
#pragma unroll
                for (int bj = 0; bj < 2; ++bj) { const int ch = wc * 32 + 8 * fq + bj * HALF;
                    bf16_t* dst = MIXp + (size_t)(tokbase + rowl) * MIXW + 512 + (ch >> 6) * 128 + cs * 64 + (ch & 63);
                    f32x4 a0 = acc[ai][bj][m][0], a1 = acc[ai][bj][m][1];
                    if (!ctx && cs == 0) { const float sg = (rowl & 1) ? -1.f : 1.f; a0 += gld<f32x4>(xh + u.pn * 256 + ch) * sg; a1 += gld<f32x4>(xh + u.pn * 256 + ch + 4) * sg; }
                    const f32x4 v0 = a0 * scale, v1 = a1 * scale;
                    u32x4 w; w.x = cvt_pk_bf16(v0[0], v0[1]); w.y = cvt_pk_bf16(v0[2], v0[3]); w.z = cvt_pk_bf16(v1[0], v1[1]); w.w = cvt_pk_bf16(v1[2], v1[3]);
                    gst<u32x4>(dst, w); } }
    }
};
__device__ __forceinline__ float dpp_ror1(float v) { return __int_as_float(__builtin_amdgcn_mov_dpp(__float_as_int(v), 0x121, 0xf, 0xf, false)); }
__device__ __forceinline__ float dpp_rol1(float v) { return __int_as_float(__builtin_amdgcn_mov_dpp(__float_as_int(v), 0x12F, 0xf, 0xf, false)); }
struct EpiConv {
    static constexpr bool PERM = true;
    bf16_t* ACT; float* EDGE; const float* cw; const float* cb;
    __device__ __forceinline__ void operator()(const f32x4 (&acc)[2][2][4][2], const Unit& u, int wr, int wc, int fr_, int fq_, LAS unsigned char* lds) const {
        int fr = fr_, fq = fq_; asm volatile("" : "+v"(fr), "+v"(fq));
        LAS float* E = (LAS float*)(lds + E_OFF);
        const int pm = u.pm, pn = u.pn;
        const bool first = pm < 16 || ((pm - 16) & 15) == 0, last = pm < 16 || ((pm - 16) & 15) == 15;
        const int lc0 = wc * 32 + 8 * fq;
#pragma unroll
        for (int ai = 0; ai < 2; ++ai) { const int G = 2 * ai + wr;
            if (fr == 0) {
#pragma unroll
                for (int bj = 0; bj < 2; ++bj)
#pragma unroll
                    for (int n = 0; n < 2; ++n) *(LAS f32x4*)(E + (G * 2 + 0) * 256 + bj * 128 + lc0 + 4 * n) = acc[ai][bj][0][n]; }
            if (fr == 15) {
#pragma unroll
                for (int bj = 0; bj < 2; ++bj)
#pragma unroll
                    for (int n = 0; n < 2; ++n) *(LAS f32x4*)(E + (G * 2 + 1) * 256 + bj * 128 + lc0 + 4 * n) = acc[ai][bj][3][n]; }
        }
        if (wr == 0 && fr < 2) {
#pragma unroll
            for (int bj = 0; bj < 2; ++bj)
#pragma unroll
                for (int n = 0; n < 2; ++n) gst<f32x4>(EDGE + ((size_t)pm * 4 + fr) * 5632 + bj * DFF + pn * 128 + lc0 + 4 * n, acc[0][bj][0][n]); }
        if (wr == 1 && fr >= 14) {
#pragma unroll
            for (int bj = 0; bj < 2; ++bj)
#pragma unroll
                for (int n = 0; n < 2; ++n) gst<f32x4>(EDGE + ((size_t)pm * 4 + 2 + (fr - 14)) * 5632 + bj * DFF + pn * 128 + lc0 + 4 * n, acc[1][bj][3][n]); }
        asm volatile("s_waitcnt lgkmcnt(0)" ::: "memory"); __builtin_amdgcn_s_barrier(); asm volatile("" ::: "memory");
#pragma unroll
        for (int ai = 0; ai < 2; ++ai) { const int G = 2 * ai + wr;
#pragma unroll
            for (int n = 0; n < 2; ++n) { const int ca = pn * 128 + lc0 + 4 * n;
                f32x4 wA[3], wG[3];
#pragma unroll
                for (int t = 0; t < 3; ++t) { wA[t] = gld<f32x4>(cw + t * 5632 + ca); wG[t] = gld<f32x4>(cw + t * 5632 + DFF + ca); }
                const f32x4 bA = gld<f32x4>(cb + ca), bG = gld<f32x4>(cb + DFF + ca);
                const f32x4 z = {0.f, 0.f, 0.f, 0.f};
                const f32x4 ePa = G > 0 ? *(LAS f32x4*)(E + ((G - 1) * 2 + 1) * 256 + lc0 + 4 * n) : z, ePg = G > 0 ? *(LAS f32x4*)(E + ((G - 1) * 2 + 1) * 256 + 128 + lc0 + 4 * n) : z;
                const f32x4 eNa = G < 3 ? *(LAS f32x4*)(E + ((G + 1) * 2 + 0) * 256 + lc0 + 4 * n) : z, eNg = G < 3 ? *(LAS f32x4*)(E + ((G + 1) * 2 + 0) * 256 + 128 + lc0 + 4 * n) : z;
#pragma unroll
                for (int m = 0; m < 4; ++m) { float res[4];
#pragma unroll
                    for (int i = 0; i < 4; ++i) {
                        const float xa = acc[ai][0][m][n][i], xg = acc[ai][1][m][n][i];
                        const float sPa = (fr == 15 && m > 0) ? acc[ai][0][m > 0 ? m - 1 : 0][n][i] : xa, sPg = (fr == 15 && m > 0) ? acc[ai][1][m > 0 ? m - 1 : 0][n][i] : xg;
                        const float sNa = (fr == 0 && m < 3) ? acc[ai][0][m < 3 ? m + 1 : 3][n][i] : xa, sNg = (fr == 0 && m < 3) ? acc[ai][1][m < 3 ? m + 1 : 3][n][i] : xg;
                        float pa = dpp_ror1(sPa), pg = dpp_ror1(sPg), na = dpp_rol1(sNa), ng = dpp_rol1(sNg);
                        if (m == 0) { pa = fr == 0 ? ePa[i] : pa; pg = fr == 0 ? ePg[i] : pg; }
                        if (m == 3) { na = fr == 15 ? eNa[i] : na; ng = fr == 15 ? eNg[i] : ng; }
                        const float ua = pa * wA[0][i] + xa * wA[1][i] + na * wA[2][i] + bA[i];
                        const float ug = pg * wG[0][i] + xg * wG[1][i] + ng * wG[2][i] + bG[i];
                        res[i] = ua * ug * __builtin_amdgcn_rcpf(1.f + __expf(-ug));
                    }
                    const int rowl = ai * HALF + wr * 64 + m * 16 + fr;
                    const bool ok = !((rowl == 0 && !first) || (rowl == 255 && !last));
                    if (ok) { u32x2 w; w.x = cvt_pk_bf16(res[0], res[1]); w.y = cvt_pk_bf16(res[2], res[3]);
                        gst<u32x2>(ACT + (size_t)(pm * BM + rowl) * DFF + pn * 128 + lc0 + 4 * n, w); }
                }
            }
        }
    }
};
}

__device__ __forceinline__ f32x4 ld_bf4(const bf16_t* p) { const u32x2 w = gld<u32x2>(p); return (f32x4){__uint_as_float(w.x << 16), __uint_as_float(w.x & 0xffff0000u), __uint_as_float(w.y << 16), __uint_as_float(w.y & 0xffff0000u)}; }
struct FaArgs {
    const bf16_t* q; int q_pitch;
    const bf16_t* kn; int kn_pitch;
    const bf16_t* kr; int kr_pitch;
    const bf16_t* vt; int vt_pitch;
    int tok0, nt0, tok1, nt1;
    int j0, qpos0;
    float sink2; int has_sink;
    bf16_t* o; int o_pitch;
    const float* cosT; const float* sinT;
};
__device__ __forceinline__ int crow(int r, int hi) { return (r & 3) + 8 * (r >> 2) + 4 * hi; }
template <int DQK, bool WINDOW, bool ROPEQ>
__device__ __forceinline__ void fa_unit(LAS unsigned char* lds, const FaArgs a) {
    constexpr int KROW = (DQK + 8) * 2, VROW = 136, BUFB = 64 * 208 + 64 * VROW, SCR = 5 * BUFB, ND = DQK / 16;
    constexpr float THR = 5.f;
    int tid_ = threadIdx.x; asm volatile("" : "+v"(tid_));
    const int tid = tid_, lane = tid & 63, r32 = lane & 31, hi = lane >> 5; const int wid = __builtin_amdgcn_readfirstlane(tid >> 6);
    LAS float* wsf = (LAS float*)(lds + SCR) + wid * 64;
    __syncthreads();
    bf16x8 qr[ND];
    const bf16_t* qrow = a.q + (size_t)(wid * 32 + r32) * a.q_pitch;
#pragma unroll
    for (int d0 = 0; d0 < ND; ++d0) qr[d0] = gld<bf16x8>(qrow + d0 * 16 + hi * 8);
    if (ROPEQ) {
        const int pos = a.qpos0 + wid * 32 + r32;
#pragma unroll
        for (int d0 = 4; d0 < ND; ++d0) {
            const int bidx = 2 * (d0 - 4) + hi;
            const bf16x8 own = qr[d0], oth = gld<bf16x8>(qrow + 64 + 8 * (bidx ^ 1));
            const int pc = (bidx < 2) ? (pos >> 6) : (pos & 63);
            const f32x4 c0 = gld<f32x4>(a.cosT + pc * 8), c1 = gld<f32x4>(a.cosT + pc * 8 + 4), s0 = gld<f32x4>(a.sinT + pc * 8), s1 = gld<f32x4>(a.sinT + pc * 8 + 4);
            float o8[8];
#pragma unroll
            for (int e = 0; e < 8; ++e) { const float xo = bf2f((bf16_t)own[e]), xp = bf2f((bf16_t)oth[e]); const float c = e < 4 ? c0[e & 3] : c1[e & 3], s = e < 4 ? s0[e & 3] : s1[e & 3];
                o8[e] = (bidx & 1) ? (xo * c + xp * s) : (xo * c - xp * s); }
            u32x4 w; w.x = cvt_pk_bf16(o8[0], o8[1]); w.y = cvt_pk_bf16(o8[2], o8[3]); w.z = cvt_pk_bf16(o8[4], o8[5]); w.w = cvt_pk_bf16(o8[6], o8[7]);
            qr[d0] = __builtin_bit_cast(bf16x8, w);
        }
    }
    const int NT = a.nt0 + a.nt1;
    u32x4 rkA, rrA = {0, 0, 0, 0}, rvA, rkB, rrB = {0, 0, 0, 0}, rvB;
#define FA_TOK(t) ((t) < a.nt0 ? a.tok0 + 64 * (t) : a.tok1 + 64 * ((t) - a.nt0))
#define FA_ISSUE(t, S) do { const int tc_ = (t) < NT ? (t) : NT - 1; const int tb_ = FA_TOK(tc_); rk##S = gld<u32x4>(a.kn + (size_t)(tb_ + (tid >> 3)) * a.kn_pitch + (tid & 7) * 8); \
        if (DQK == 96) { if (tid < 256) rr##S = gld<u32x4>(a.kr + (size_t)(tb_ + (tid >> 2)) * a.kr_pitch + (tid & 3) * 8); } \
        rv##S = gld<u32x4>(a.vt + (size_t)(tid >> 3) * a.vt_pitch + tb_ + (tid & 7) * 8); } while (0)
#define FA_WRITE(buf, S) do { LAS unsigned char* kb_ = lds + (buf) * BUFB; *(LAS u32x4*)(kb_ + (tid >> 3) * KROW + (tid & 7) * 16) = rk##S; \
        if (DQK == 96) { if (tid < 256) *(LAS u32x4*)(kb_ + (tid >> 2) * KROW + 128 + (tid & 3) * 16) = rr##S; } \
        { LAS unsigned char* vd_ = kb_ + 64 * 208 + (tid >> 3) * VROW + (tid & 7) * 16; *(LAS u32x2*)vd_ = (u32x2){rv##S.x, rv##S.y}; *(LAS u32x2*)(vd_ + 8) = (u32x2){rv##S.z, rv##S.w}; } } while (0)
#define FA_KLOADH(buf, h) do { const LAS unsigned char* Kb_ = lds + (buf) * BUFB; \
        _Pragma("unroll") for (int d1 = 0; d1 < ND / 2; ++d1) { const int d0 = (h) * (ND / 2) + d1; \
            kf[2 * d1] = *(const LAS bf16x8*)(Kb_ + r32 * KROW + d0 * 32 + hi * 16); \
            kf[2 * d1 + 1] = *(const LAS bf16x8*)(Kb_ + (32 + r32) * KROW + d0 * 32 + hi * 16); } } while (0)
#define FA_QKMH(P0, P1, h) do { \
        _Pragma("unroll") for (int d1 = 0; d1 < ND / 2; ++d1) { const int d0 = (h) * (ND / 2) + d1; \
            if ((h) == 0 && d1 == 0) { P0 = __builtin_amdgcn_mfma_f32_32x32x16_bf16(kf[0], qr[0], negm, 0, 0, 0); P1 = __builtin_amdgcn_mfma_f32_32x32x16_bf16(kf[1], qr[0], negm, 0, 0, 0); } \
            else { P0 = __builtin_amdgcn_mfma_f32_32x32x16_bf16(kf[2 * d1], qr[d0], P0, 0, 0, 0); P1 = __builtin_amdgcn_mfma_f32_32x32x16_bf16(kf[2 * d1 + 1], qr[d0], P1, 0, 0, 0); } } } while (0)
    bf16x8 kf[ND];
    float mhat = 0.f, lsum = 0.f;
    f32x16 negm = {};
    f32x16 o0 = {}, o1 = {};
    f32x16 sc0, sc1, sn0, sn1;
    int s0 = 0;
#define FA_W5(x) ((x) >= 5 ? (x) - 5 : (x))
#define FA_MX(a_, b_) __builtin_amdgcn_fmed3f((a_), (b_), __builtin_inff())
    FA_ISSUE(0, A); FA_ISSUE(1, B); FA_WRITE(0, A); FA_ISSUE(2, A); FA_WRITE(1, B); FA_ISSUE(3, B); FA_WRITE(2, A); __syncthreads();
    FA_KLOADH(0, 0); FA_QKMH(sc0, sc1, 0); FA_KLOADH(0, 1); FA_QKMH(sc0, sc1, 1);
#define FA_STEP(t, RW, RL, BAR) do { \
        FA_KLOADH(FA_W5(s0 + 1), 0); \
        if (WINDOW) { if ((t) < a.nt0) { \
            const int qp = a.qpos0 + wid * 32 + r32, jb = a.j0 + 64 * (t); \
            _Pragma("unroll") for (int r = 0; r < 16; ++r) { const int d0_ = qp - (jb + crow(r, hi)), d1_ = d0_ - 32; \
                if (d0_ > 128 || d0_ < -128) sc0[r] = -1e30f; if (d1_ > 128 || d1_ < -128) sc1[r] = -1e30f; } } } \
        float rm = FA_MX(sc0[0], sc1[0]); \
        if (WINDOW) { _Pragma("unroll") for (int r = 1; r < 16; ++r) rm = FA_MX(rm, FA_MX(sc0[r], sc1[r])); } \
        else { rm = FA_MX(FA_MX(rm, sc0[5]), FA_MX(sc0[10], sc0[15])); rm = FA_MX(FA_MX(rm, sc1[2]), FA_MX(sc1[7], sc1[13])); }     \
        { auto rr_ = __builtin_amdgcn_permlane32_swap(__float_as_uint(rm), __float_as_uint(rm), false, false); rm = FA_MX(__uint_as_float(rr_[0]), __uint_as_float(rr_[1])); } \
        if ((t) == 0 || __any(rm > THR)) { \
            const float dl = (t) == 0 ? FA_MX(rm, -100.f) : FA_MX(rm, 0.f); const float f = __builtin_amdgcn_exp2f(-dl); \
            lsum *= f; mhat += dl; \
            _Pragma("unroll") for (int r = 0; r < 16; ++r) { sc0[r] -= dl; sc1[r] -= dl; negm[r] = -mhat; } \
            if (hi == 0) wsf[r32] = f; \
            LDS_WAIT(); \
            _Pragma("unroll") for (int r = 0; r < 16; ++r) { const float fr_ = wsf[crow(r, hi)]; o0[r] *= fr_; o1[r] *= fr_; } \
        } \
        __builtin_amdgcn_sched_barrier(0); \
        FA_ISSUE((t) + 4, RL); \
        FA_QKMH(sn0, sn1, 0); FA_KLOADH(FA_W5(s0 + 1), 1); \
        float ps0 = 0.f, ps1 = 0.f, ps2 = 0.f, ps3 = 0.f; \
        _Pragma("unroll") for (int r = 0; r < 16; r += 2) { sc0[r] = __builtin_amdgcn_exp2f(sc0[r]); sc1[r] = __builtin_amdgcn_exp2f(sc1[r]); sc0[r + 1] = __builtin_amdgcn_exp2f(sc0[r + 1]); sc1[r + 1] = __builtin_amdgcn_exp2f(sc1[r + 1]); \
            ps0 += sc0[r]; ps1 += sc1[r]; ps2 += sc0[r + 1]; ps3 += sc1[r + 1]; } \
        lsum += (ps0 + ps1) + (ps2 + ps3); \
        FA_QKMH(sn0, sn1, 1); \
        u32x4 pw[4]; \
        _Pragma("unroll") for (int k = 0; k < 2; ++k) { \
            pw[k]     = (u32x4){cvt_pk_bf16(sc0[8 * k], sc0[8 * k + 1]), cvt_pk_bf16(sc0[8 * k + 2], sc0[8 * k + 3]), cvt_pk_bf16(sc0[8 * k + 4], sc0[8 * k + 5]), cvt_pk_bf16(sc0[8 * k + 6], sc0[8 * k + 7])}; \
            pw[2 + k] = (u32x4){cvt_pk_bf16(sc1[8 * k], sc1[8 * k + 1]), cvt_pk_bf16(sc1[8 * k + 2], sc1[8 * k + 3]), cvt_pk_bf16(sc1[8 * k + 4], sc1[8 * k + 5]), cvt_pk_bf16(sc1[8 * k + 6], sc1[8 * k + 7])}; } \
        { const LAS unsigned char* Vb = lds + s0 * BUFB + 64 * 208; \
        _Pragma("unroll") for (int ks = 0; ks < 4; ++ks) { \
            const bf16x8 pa = __builtin_bit_cast(bf16x8, pw[ks]); \
            _Pragma("unroll") for (int dh = 0; dh < 2; ++dh) { \
                const LAS unsigned char* vp = Vb + (dh * 32 + r32) * VROW + (16 * ks + 4 * hi) * 2; \
                const s16x4 vl = *(const LAS s16x4*)vp, vh = *(const LAS s16x4*)(vp + 16); \
                const bf16x8 vb = {vl[0], vl[1], vl[2], vl[3], vh[0], vh[1], vh[2], vh[3]}; \
                if (dh == 0) o0 = __builtin_amdgcn_mfma_f32_32x32x16_bf16(pa, vb, o0, 0, 0, 0); else o1 = __builtin_amdgcn_mfma_f32_32x32x16_bf16(pa, vb, o1, 0, 0, 0); } } } \
        __builtin_amdgcn_sched_group_barrier(0x020, 3, 0); __builtin_amdgcn_sched_group_barrier(0x100, 16, 0); \
        _Pragma("unroll") for (int i_ = 0; i_ < 2 * ND; ++i_) { __builtin_amdgcn_sched_group_barrier(0x008, 1, 0); __builtin_amdgcn_sched_group_barrier(0x002, (DQK == 96 ? 7 : 10), 0); } \
        _Pragma("unroll") for (int i_ = 0; i_ < 8; ++i_) { __builtin_amdgcn_sched_group_barrier(0x008, 1, 0); __builtin_amdgcn_sched_group_barrier(0x002, 4, 0); } \
        __builtin_amdgcn_sched_barrier(0); \
        FA_WRITE(FA_W5(s0 + 3), RW); \
        if (BAR) __syncthreads(); \
        sc0 = sn0; sc1 = sn1; s0 = FA_W5(s0 + 1); \
    } while (0)
    for (int t = 0; t < NT; t += 2) { FA_STEP(t, B, A, false); FA_STEP(t + 1, A, B, true); }
#undef FA_W5
#undef FA_MX
#undef FA_STEP
#undef FA_QKMH
#undef FA_KLOADH
    lsum += __shfl_xor(lsum, 32);
    if (a.has_sink) lsum += __builtin_amdgcn_exp2f(a.sink2 - mhat);
    const float inv = 1.f / lsum;
    if (hi == 0) wsf[r32] = inv;
    LDS_WAIT();
#pragma unroll
    for (int r = 0; r < 16; ++r) { const int qq = crow(r, hi); const float s = wsf[qq];
        bf16_t* op = a.o + (size_t)(wid * 32 + qq) * a.o_pitch + r32;
        gst<bf16_t>(op, f2bf(o0[r] * s)); gst<bf16_t>(op + 32, f2bf(o1[r] * s)); }
#undef FA_TOK
#undef FA_ISSUE
#undef FA_WRITE
}


#define XB_TMO      128
#define XB_XCNT(j)  (256  + 64 * (j))
#define XB_XSUB(j)  (1280 + 64 * (j))
#define XB_XGEN(j)  (2304 + 64 * (j))
#define XB_TOP      3328
#define XB_TOPGEN   3392
#define XCD_BAR_WORDS 3456
#define XB_SPIN_CAP (1u << 22)
__device__ __forceinline__ unsigned xb_ld(unsigned* p)              { return __hip_atomic_load(p, __ATOMIC_RELAXED, __HIP_MEMORY_SCOPE_AGENT); }
__device__ __forceinline__ unsigned xb_add(unsigned* p, unsigned v) { return __hip_atomic_fetch_add(p, v, __ATOMIC_RELAXED, __HIP_MEMORY_SCOPE_AGENT); }
__device__ __forceinline__ unsigned xb_xcc_id() { return (unsigned)__builtin_amdgcn_s_getreg((3 << 11) | 20) & 0xFu; }
#define XB_SPIN(cond, bar) do { unsigned _sp = 0; while (cond) { __builtin_amdgcn_s_sleep(1); \
    if ((++_sp & 255u) == 0u) { if (xb_ld(&(bar)[XB_TMO])) break; if (_sp > XB_SPIN_CAP) { atomicAdd(&(bar)[XB_TMO], 1u); break; } } } } while (0)
__device__ __forceinline__ void xcd_barrier_complete(unsigned* bar, unsigned x, unsigned& nloc, unsigned& nx) {
    const unsigned G = gridDim.x * gridDim.y * gridDim.z;
    unsigned sum, cnt, mine, sp = 0u;
    for (;;) {
        sum = 0u; cnt = 0u; mine = 0u;
#pragma unroll
        for (unsigned j = 0; j < 16; ++j) { const unsigned c = xb_ld(&bar[XB_XCNT(j)]); sum += c; cnt += (c > 0u) ? 1u : 0u; mine = (j == x) ? c : mine; }
        if (sum == G) break;
        __builtin_amdgcn_s_sleep(1);
        if ((++sp & 255u) == 0u) { if (xb_ld(&bar[XB_TMO])) break; if (sp > XB_SPIN_CAP) { atomicAdd(&bar[XB_TMO], 1u); break; } }
    }
    nloc = mine > 0u ? mine : 1u; nx = cnt > 0u ? cnt : 1u;
}
__device__ __forceinline__ void xcd_barrier(unsigned* bar, volatile LAS unsigned* st) {
    asm volatile("s_waitcnt vmcnt(0)" ::: "memory");
    __syncthreads();
    if (threadIdx.x == 0) {
        const unsigned x = xb_xcc_id();
        __builtin_amdgcn_s_waitcnt(0);
        unsigned nloc = st[0], nx = st[1];
        if (nloc == 0u) { xcd_barrier_complete(bar, x, nloc, nx); st[0] = nloc; st[1] = nx; }
        const unsigned old = xb_add(&bar[XB_XSUB(x)], 1u);
        const unsigned gen = old / nloc;
        if (old + 1u == (gen + 1u) * nloc) {
            __builtin_amdgcn_fence(__ATOMIC_RELEASE, "agent");
            asm volatile("s_waitcnt vmcnt(0)" ::: "memory");
            const unsigned og = xb_add(&bar[XB_TOP], 1u);
            const unsigned tg = og / nx;
            if (og + 1u == (tg + 1u) * nx) xb_add(&bar[XB_TOPGEN], 1u);
            else XB_SPIN(xb_ld(&bar[XB_TOPGEN]) == tg, bar);
            __builtin_amdgcn_fence(__ATOMIC_ACQUIRE, "agent");
            xb_add(&bar[XB_XGEN(x)], 1u);
            asm volatile("s_waitcnt vmcnt(0)" ::: "memory");
        } else {
            XB_SPIN(xb_ld(&bar[XB_XGEN(x)]) == gen, bar);
            __builtin_amdgcn_fence(__ATOMIC_ACQUIRE, "agent");
            asm volatile("s_waitcnt vmcnt(0)" ::: "memory");
        }
    }
    __syncthreads();
}

constexpr int ARG_OFF = LDS_BYTES - 512;
__device__ __forceinline__ unsigned long long lds_arg(LAS unsigned char* lds, int i) {
    int off = ARG_OFF + 8 * i; asm volatile("" : "+v"(off));
    const unsigned long long v = *(const LAS unsigned long long*)(lds + off);
    const unsigned lo = __builtin_amdgcn_readfirstlane((unsigned)v), hi = __builtin_amdgcn_readfirstlane((unsigned)(v >> 32));
    return ((unsigned long long)hi << 32) | lo;
}
#define INP(i) ((const float*)lds_arg(lds, (i)))
struct Args { const float* in[24]; float* out; unsigned char* ws; int use_cg, pad; };
enum { I_XP = 0, I_XS, I_CWK, I_CWV, I_CCKV, I_CKR, I_C, I_CCTX, I_WADA, I_BADA, I_GMIX, I_WIN, I_SINK, I_GCQ, I_WUQ, I_GCKV, I_WUKV, I_WOUT, I_GFFN, I_WUG, I_CONVW, I_CONVB, I_WDOWN, I_GFINAL };

__device__ __forceinline__ void transpose_item(const float* W, int srcN, int ksrc0, int kvalid, int scol0, bf16_t* dst, int dpitch, const float* kscale, float scale, LAS float* scr, int lane) {
    float tv[32];
#pragma unroll
    for (int i = 0; i < 32; ++i) { const int k = ksrc0 + 2 * i + (lane >> 5); tv[i] = 0.f;
        if (scol0 >= 0 && k < kvalid) tv[i] = W[(size_t)k * srcN + scol0 + (lane & 31)]; }
#pragma unroll
    for (int i = 0; i < 32; ++i) { const int kk = 2 * i + (lane >> 5), k = ksrc0 + kk; float v = tv[i] * scale;
        if (kscale) { if (scol0 >= 0 && k < kvalid) v *= kscale[k]; }
        scr[kk * 33 + (lane & 31)] = v; }
    LDS_WAIT(); asm volatile("" ::: "memory");
    const int c = lane & 7;
#pragma unroll
    for (int j = 0; j < 4; ++j) { const int n = (lane >> 3) + 8 * j; const LAS float* s = scr + (8 * c) * 33 + n;
        u32x4 o; o.x = cvt_pk_bf16(s[0 * 33], s[1 * 33]); o.y = cvt_pk_bf16(s[2 * 33], s[3 * 33]); o.z = cvt_pk_bf16(s[4 * 33], s[5 * 33]); o.w = cvt_pk_bf16(s[6 * 33], s[7 * 33]);
        *(u32x4*)(dst + (size_t)n * dpitch + 8 * c) = o; }
    LDS_WAIT(); asm volatile("" ::: "memory");
}

__global__ void __launch_bounds__(512, 2) mk_fwd(Args args) {
    extern __shared__ __attribute__((aligned(16))) unsigned char lds_raw[];
    LAS unsigned char* lds = (LAS unsigned char*)lds_raw;
    cg::grid_group grid = cg::this_grid();
    const int tid0 = threadIdx.x;
    if (tid0 < 24) ((LAS unsigned long long*)(lds + ARG_OFF))[tid0] = (unsigned long long)args.in[tid0];
    if (tid0 == 24) ((LAS unsigned long long*)(lds + ARG_OFF))[24] = (unsigned long long)args.out;
    if (tid0 == 25) ((LAS unsigned long long*)(lds + ARG_OFF))[25] = (unsigned long long)args.ws;
    if (tid0 == 26) { ((LAS unsigned*)(lds + ARG_OFF + 256))[0] = 0u; ((LAS unsigned*)(lds + ARG_OFF + 256))[1] = 0u; }
    if (tid0 == 0) (void)xb_add((unsigned*)args.ws + XB_XCNT(xb_xcc_id()), 1u);
    __syncthreads();
#define WS_PTRS \
    int tidl_ = threadIdx.x; asm volatile("" : "+v"(tidl_)); const int tid = tidl_, lane = tid & 63, wave = __builtin_amdgcn_readfirstlane(tid >> 6); \
    int bxl_ = blockIdx.x; asm volatile("" : "+s"(bxl_)); const int G = gridDim.x, bx = bxl_; const int vcu = (G % 8 == 0) ? (bx % 8) * (G / 8) + bx / 8 : bx; \
    const int gw = vcu * 8 + wave, NGW = G * 8, gt = bx * 512 + tid, GT = G * 512; (void)gw; (void)NGW; (void)gt; (void)GT; (void)lane; \
    unsigned char* ws = (unsigned char*)lds_arg(lds, 25); float* out = (float*)lds_arg(lds, 24); \
    float* MOD = (float*)(ws + WS_MOD); \
    float* cosA = (float*)(ws + WS_TAB + T_COSA); float* sinA = (float*)(ws + WS_TAB + T_SINA); float* cosC = (float*)(ws + WS_TAB + T_COSC); float* sinC = (float*)(ws + WS_TAB + T_SINC); \
    bf16_t* TABC = (bf16_t*)(ws + WS_TAB + T_TABC); bf16_t* TABS = (bf16_t*)(ws + WS_TAB + T_TABS); bf16_t* DFT256 = (bf16_t*)(ws + WS_DFT256); \
    bf16_t* H = (bf16_t*)(ws + WS_H); bf16_t* MIX = (bf16_t*)(ws + WS_H); \
    bf16_t* PROJ = (bf16_t*)(ws + WS_PROJ); bf16_t* DFT = (bf16_t*)(ws + WS_DFT); \
    bf16_t* QA = (bf16_t*)(ws + WS_QA); bf16_t* KA = (bf16_t*)(ws + WS_KA); bf16_t* CQN = (bf16_t*)(ws + WS_CQN); bf16_t* CKVN = (bf16_t*)(ws + WS_CKVN); \
    bf16_t* QC = (bf16_t*)(ws + WS_QC); bf16_t* KC = (bf16_t*)(ws + WS_KC); bf16_t* VT = (bf16_t*)(ws + WS_VT); bf16_t* KR = (bf16_t*)(ws + WS_KR); bf16_t* XT = (bf16_t*)(ws + WS_XT); \
    bf16_t* ACT = (bf16_t*)(ws + WS_ACT); float* EDGE = (float*)(ws + WS_EDGE);
#ifndef REP_P5
#define REP_P5 1
#endif
#ifndef REP_P3
#define REP_P3 1
#endif
#ifndef REP_P4
#define REP_P4 1
#endif
#ifndef REP_P8
#define REP_P8 1
#endif
#ifndef REP_P0
#define REP_P0 1
#endif
#ifndef REP_P2
#define REP_P2 1
#endif
#ifndef REP_P1
#define REP_P1 1
#endif
#define PH_BEGIN { WS_PTRS
#define PH_BEGIN_L PH_BEGIN unsigned char* wl = ws + WS_W + (size_t)l * W_LSTRIDE; const float* modl = MOD + (size_t)l * 5 * 6144; (void)wl; (void)modl;
#define PH_END   xcd_barrier((unsigned*)ws, (volatile LAS unsigned*)(lds + ARG_OFF + 256)); }
#define PH_END_CG xcd_barrier((unsigned*)ws, (volatile LAS unsigned*)(lds + ARG_OFF + 256)); if (args.use_cg) grid.sync(); }

    for (int rep_ = 0; rep_ < REP_P0; ++rep_)
    PH_BEGIN
    {
        LAS float* red = (LAS float*)lds;
        LAS float* sil = (LAS float*)(lds + 16384);
        if (bx < 192) {
            for (int i = tid; i < 5 * 1024; i += 512) { const int j = i >> 10, k = i & 1023; const float cv = j == 0 ? INP(I_CCTX)[k] : INP(I_C)[(j - 1) * DM + k]; sil[i] = cv / (1.f + __expf(-cv)); }
            __syncthreads();
        }
        for (int it = bx; it < 192; it += G) {
            const int l = it / 96, cgp = it % 96, col = cgp * 64 + lane;
            const float* wa = INP(I_WADA) + (size_t)l * DM * 6144 + col;
            float ac[5] = {0.f, 0.f, 0.f, 0.f, 0.f};
#pragma unroll 16
            for (int kk = 0; kk < 128; ++kk) { const int k = wave * 128 + kk; const float wv = wa[(size_t)k * 6144];
#pragma unroll
                for (int j = 0; j < 5; ++j) ac[j] += sil[j * 1024 + k] * wv; }
#pragma unroll
            for (int j = 0; j < 5; ++j) red[(wave * 5 + j) * 64 + lane] = ac[j];
            __syncthreads();
            if (tid < 320) { const int j = tid >> 6; float s = 0.f;
#pragma unroll
                for (int w = 0; w < 8; ++w) s += red[(w * 5 + j) * 64 + lane];
                MOD[(size_t)(l * 5 + j) * 6144 + col] = s + INP(I_BADA)[l * 6144 + col]; }
            __syncthreads();
        }
    }
    {
        LAS float* t64 = (LAS float*)(lds + 120000);
        if (tid < 64) { t64[tid] = cospif((float)tid * (1.f / 32.f)); t64[64 + tid] = -sinpif((float)tid * (1.f / 32.f)); }
        __syncthreads();
        LAS float* scr = (LAS float*)(lds) + wave * (64 * 33);
        constexpr int J0 = 768, J1 = 256, J2 = 128, J3 = 2816, J4 = 1408, J5 = 64, J6 = 16, J7 = 16, J8 = 1024, JL = J0 + J1 + J2 + J3 + J4 + J5 + J6 + J7;
        const int wrk_ = bx * 8 + wave, nex_ = (bx >= 192 && G == 256) ? 4 : 0, nbase_ = (G == 256) ? 2048 : 0;
        for (int k_ = 0;; ++k_) {
            const int it = k_ < nex_ ? (wrk_ - 1536) + k_ * 512 : nbase_ + wrk_ + (k_ - nex_) * NGW;
            if (it >= 2 * J8 + 2 * JL) break;
            if (it < 2 * J8) {
                const int l = it / J8, r = it % J8, cb = r & 7, g = (r >> 3) / 32, nb = (r >> 3) % 32; const float* W = INP(I_WOUT) + (size_t)l * DM * DM;
                unsigned char* wl = ws + WS_W + (size_t)l * W_LSTRIDE;
                float tv[32];
#pragma unroll
                for (int i = 0; i < 32; ++i) tv[i] = W[(size_t)(512 + g * 64 + 2 * i + (lane >> 5)) * 1024 + nb * 32 + (lane & 31)];
#pragma unroll
                for (int i = 0; i < 32; ++i) scr[(2 * i + (lane >> 5)) * 33 + (lane & 31)] = tv[i];
                LDS_WAIT(); asm volatile("" ::: "memory");
                const int n = lane & 31, cs = lane >> 5;
                bf16_t* dst = (bf16_t*)(wl + WO_OUT) + (size_t)(nb * 32 + n) * MIXW + 512 + g * 128 + cs * 64;
                float a8[8] = {0.f, 0.f, 0.f, 0.f, 0.f, 0.f, 0.f, 0.f};
                for (int cp = 0; cp < 64; ++cp) { const float w = scr[cp * 33 + n];
#pragma unroll
                    for (int e = 0; e < 8; ++e) { const int id = ((cb * 8 + e) * cp) & 63; a8[e] += t64[cs * 64 + id] * w; } }
                u32x4 o; o.x = cvt_pk_bf16(a8[0], a8[1]); o.y = cvt_pk_bf16(a8[2], a8[3]); o.z = cvt_pk_bf16(a8[4], a8[5]); o.w = cvt_pk_bf16(a8[6], a8[7]);
                *(u32x4*)(dst + cb * 8) = o;
                LDS_WAIT(); asm volatile("" ::: "memory");
                continue;
            }
            const int itw = it - 2 * J8;
            const int l = itw / JL; int r = itw % JL;
            unsigned char* wl = ws + WS_W + (size_t)l * W_LSTRIDE;
            if (r < J0) { const int kb = r / 48, nb = r % 48; const float* W = INP(I_WIN) + (size_t)l * DM * 1376;
                transpose_item(W, 1376, kb * 64, 1024, nb < 43 ? nb * 32 : -1, (bf16_t*)(wl + WO_IN) + (size_t)(nb * 32) * 1024 + kb * 64, 1024, nullptr, 1.f, scr, lane); continue; } r -= J0;
            if (r < J1) { const int kb = r / 32, nb = r % 32; const float* W = INP(I_WOUT) + (size_t)l * DM * DM;
                transpose_item(W, 1024, kb * 64, 1024, nb * 32, (bf16_t*)(wl + WO_OUT) + (size_t)(nb * 32) * MIXW + kb * 64, MIXW, nullptr, 1.f, scr, lane); continue; } r -= J1;
            if (r < J2) { const int kb = r / 32, nb = r % 32; const float* W = INP(I_WOUT) + (size_t)l * DM * DM;
                transpose_item(W, 1024, 768 + kb * 64, 1024, nb * 32, (bf16_t*)(wl + WO_OUT) + (size_t)(nb * 32) * MIXW + 1024 + kb * 64, MIXW, nullptr, 1.f, scr, lane); continue; } r -= J2;
            if (r < J3) { const int kb = r / 176, nb = r % 176; const float* W = INP(I_WUG) + (size_t)l * DM * 5632;
                const int n0 = nb * 32, pn = n0 >> 8, rr = n0 & 255; const int sc = rr < 128 ? 128 * pn + rr : DFF + 128 * pn + (rr - 128);
                transpose_item(W, 5632, kb * 64, 1024, sc, (bf16_t*)(wl + WO_UG) + (size_t)n0 * 1024 + kb * 64, 1024, nullptr, 1.f, scr, lane); continue; } r -= J3;
            if (r < J4) { const int kb = r / 32, nb = r % 32; const float* W = INP(I_WDOWN) + (size_t)l * DFF * DM;
                transpose_item(W, 1024, kb * 64, DFF, nb * 32, (bf16_t*)(wl + WO_DN) + (size_t)(nb * 32) * DFF + kb * 64, DFF, nullptr, 1.f, scr, lane); continue; } r -= J4;
            if (r < J5) { const int kb = r / 16, nb = r % 16; const float* W = INP(I_WUQ) + (size_t)l * 192 * 384;
                transpose_item(W, 384, kb * 64, 192, nb < 12 ? nb * 32 : -1, (bf16_t*)(wl + WO_UQ) + (size_t)(nb * 32) * 256 + kb * 64, 256, INP(I_GCQ) + l * 192, QS_C, scr, lane); continue; } r -= J5;
            if (r < J6) { const int kb = r / 8, nb = r % 8; const float* W = INP(I_WUKV) + (size_t)l * 128 * 512; const int n0 = nb * 32;
                transpose_item(W, 512, kb * 64, 128, (n0 >> 6) * 128 + (n0 & 63), (bf16_t*)(wl + WO_WK) + (size_t)n0 * 128 + kb * 64, 128, nullptr, 1.f, scr, lane); continue; } r -= J6;
            if (r < J7) { const int kb = r / 8, nb = r % 8; const float* W = INP(I_WUKV) + (size_t)l * 128 * 512; const int n0 = nb * 32;
                transpose_item(W, 512, kb * 64, 128, (n0 >> 6) * 128 + 64 + (n0 & 63), (bf16_t*)(wl + WO_WV) + (size_t)n0 * 128 + kb * 64, 128, nullptr, 1.f, scr, lane); continue; } r -= J7;
        }
    }
    {
        for (int i = gt; i < 1024; i += GT) { const int p = i >> 4, k = i & 15; const float ang = (float)p * powf(10000.f, -(float)k / 16.f); cosA[i] = cosf(ang); sinA[i] = sinf(ang); }
        for (int i = gt; i < 512; i += GT) { const int p = i >> 3, k = i & 7; const float ang = (float)p * powf(10000.f, -(float)k / 8.f); cosC[i] = cosf(ang); sinC[i] = sinf(ang); }
        for (int i = gt; i < 4096; i += GT) { TABC[i] = f2bf(cospif((float)i * (1.f / 2048.f))); TABS[i] = f2bf(sinpif((float)i * (1.f / 2048.f))); }
        for (int i = gt; i < 512 * 256; i += GT) { const int row = i >> 8, n = i & 255, cs = row >> 8, kp = row & 255; const int id = (kp * n) & 255;
            DFT256[i] = f2bf(cs ? sinpif((float)id * (1.f / 128.f)) : cospif((float)id * (1.f / 128.f))); }
    }
    PH_END_CG

    for (int l = 0; l < 2; ++l) {
        for (int rep_ = 0; rep_ < REP_P1; ++rep_)
        PH_BEGIN_L
#define P1_XR(r) ((l == 0) ? ((r) < NCTX ? xp_ + (size_t)(r) * DM : xs_ + (size_t)((r) - NCTX) * DM) : out + (size_t)(r) * DM)
        const float* xp_ = INP(I_XP); const float* xs_ = INP(I_XS);
        f32x4 nv[4], nw[4];
#pragma unroll
        for (int j = 0; j < 4; ++j) { nv[j] = gld<f32x4>(P1_XR(gw) + 4 * lane + 256 * j); nw[j] = gld<f32x4>(P1_XR(gw + NGW) + 4 * lane + 256 * j); }
        for (int row = gw; row < NTOK; row += NGW) {
            const int mi = row < NCTX ? 0 : 1 + ((row - NCTX) >> 12);
            const float* sh = modl + mi * 6144, *sc = sh + 1024; const float* gm = INP(I_GMIX) + l * DM;
            f32x4 v[4]; float s = 0.f;
#pragma unroll
            for (int j = 0; j < 4; ++j) { v[j] = nv[j]; nv[j] = nw[j]; }
            { const int nr = row + 2 * NGW < NTOK ? row + 2 * NGW : row;
#pragma unroll
                for (int j = 0; j < 4; ++j) nw[j] = gld<f32x4>(P1_XR(nr) + 4 * lane + 256 * j); }
#pragma unroll
            for (int j = 0; j < 4; ++j) {
                if (l == 1 && row >= 16384) { const size_t po = (size_t)(row - 16384) * DM + 4 * lane + 256 * j; const bf16_t* pa = (const bf16_t*)(ws + 207 * MiB); const bf16_t* pb = (const bf16_t*)(ws + WS_W);
                    const f32x4 ps = (ld_bf4(pa + po) + ld_bf4(pa + 4194304 + po)) + (ld_bf4(pa + 2 * 4194304 + po) + ld_bf4(pb + po));
                    v[j] += *(const f32x4*)(MOD + 4 * 6144 + 5120 + 4 * lane + 256 * j) * ps; *(f32x4*)(out + (size_t)row * DM + 4 * lane + 256 * j) = v[j]; }
                s += v[j][0] * v[j][0] + v[j][1] * v[j][1] + v[j][2] * v[j][2] + v[j][3] * v[j][3]; }
            const float rstd = rsqrtf(wave_sum(s) * (1.f / DM) + EPSN);
            if (l == 0 && row >= 16384) {
#pragma unroll
                for (int j = 0; j < 4; ++j) *(f32x4*)(out + (size_t)row * DM + 4 * lane + 256 * j) = v[j]; }
#pragma unroll
            for (int j = 0; j < 4; ++j) { const int c = 4 * lane + 256 * j; const f32x4 g4 = *(const f32x4*)(gm + c), s4 = *(const f32x4*)(sc + c), h4 = *(const f32x4*)(sh + c);
                const f32x4 y = v[j] * rstd * g4 * (s4 + 1.f) + h4;
                u32x2 w; w.x = cvt_pk_bf16(y[0], y[1]); w.y = cvt_pk_bf16(y[2], y[3]); *(u32x2*)(H + (size_t)row * DM + c) = w; }
        }
        PH_END
        for (int rep_ = 0; rep_ < REP_P2; ++rep_)
        PH_BEGIN_L
        { pg8::Gemm g{H, (const bf16_t*)(wl + WO_IN), 1024, 1024, 1024, 256u * 1024 * 2, 256u * 1024 * 2}; pg8::StaticOrder S; S.init(80, 6, G, bx, 16);
          pg8::EpiStore E{PROJ, NPROJ, NPROJ, 1.f}; pg8::gemm_phase(lds, g, S, E); }
        PH_END
        for (int rep_ = 0; rep_ < REP_P3; ++rep_)
        PH_BEGIN_L
        { LAS float* tl = (LAS float*)lds;
          for (int i = tid; i < 1024; i += 512) { tl[i] = cosA[i]; tl[1024 + i] = sinA[i]; }
          tl[2048 + tid] = cosC[tid]; tl[2560 + tid] = sinC[tid];
          __syncthreads(); }
        u32x4 nrw[3];
#pragma unroll
        for (int j = 0; j < 3; ++j) { const int ch = lane + 64 * j < 172 ? lane + 64 * j : 171; nrw[j] = gld<u32x4>(PROJ + (size_t)gw * NPROJ + ch * 8); }
        for (int row = gw; row < NTOK + 1024; row += NGW) {
            if (row >= NTOK) {
                const int j = row - NTOK, b = j >> 8, jj = j & 255; const size_t src = ((size_t)(b * 2 + l) * 256 + jj);
#pragma unroll
                for (int e = 0; e < 2; ++e) { const int c = lane + 64 * e;
                    KA[(size_t)row * 128 + c] = f2bf(INP(I_CWK)[src * 128 + c]);
                    XT[(size_t)c * TOKP + row] = f2bf(INP(I_CWV)[src * 128 + c]);
                    CKVN[(size_t)row * 128 + c] = f2bf(INP(I_CCKV)[src * 128 + c]); }
                if (lane < 32) KR[(size_t)row * 32 + lane] = f2bf(INP(I_CKR)[src * 32 + lane]);
                continue;
            }
            const bf16_t* pr = PROJ + (size_t)row * NPROJ;
            LAS unsigned char* wrow = lds + 12288 + wave * 2816;
#pragma unroll
            for (int j = 0; j < 3; ++j) { const int ch = lane + 64 * j; if (ch < 172) *(LAS u32x4*)(wrow + ch * 16) = nrw[j]; }
            { const bf16_t* npr = row + NGW < NTOK ? pr + (size_t)NGW * NPROJ : pr;
#pragma unroll
                for (int j = 0; j < 3; ++j) { const int ch = lane + 64 * j < 172 ? lane + 64 * j : 171; nrw[j] = gld<u32x4>(npr + ch * 8); } }
            LDS_WAIT(); asm volatile("" ::: "memory");
            const bool ctx = row < NCTX; const int pos = ctx ? 0 : (row - NCTX) & 4095; const int prr = pos >> 6, pcc = pos & 63;
            const size_t srow = ctx ? ((size_t)((row >> 8) * 2 + l) * 256 + (row & 255)) : 0;
            const LAS float* tcA = (const LAS float*)lds; const LAS float* tsA = tcA + 1024; const LAS float* tcC = tcA + 2048; const LAS float* tsC = tcA + 2560;
            {
#pragma unroll
                for (int part = 0; part < 2; ++part) {
                    if (part == 1 && lane >= 16) break;
                    const int hh = lane >> 3, cc = lane & 7, base = (part ? 512 : 0) + hh * 64;
                    const bf16x8 own = *(const LAS bf16x8*)(wrow + (base + 8 * cc) * 2), oth = *(const LAS bf16x8*)(wrow + (base + 8 * (cc ^ 2)) * 2);
                    const int pc = (cc & 4) ? pcc : prr; const LAS float* cp = tcA + pc * 16 + 8 * (cc & 1); const LAS float* sp = tsA + pc * 16 + 8 * (cc & 1);
                    float y[8];
#pragma unroll
                    for (int e = 0; e < 8; ++e) { const float xo = bf2f((bf16_t)own[e]), xp = bf2f((bf16_t)oth[e]);
                        y[e] = ctx ? xo : ((cc & 2) ? xo * cp[e] + xp * sp[e] : xo * cp[e] - xp * sp[e]); }
                    if (part == 0) { const float q = QS_A; u32x4 w; w.x = cvt_pk_bf16(y[0] * q, y[1] * q); w.y = cvt_pk_bf16(y[2] * q, y[3] * q); w.z = cvt_pk_bf16(y[4] * q, y[5] * q); w.w = cvt_pk_bf16(y[6] * q, y[7] * q);
                        gst<u32x4>(QA + (size_t)row * 512 + hh * 64 + 8 * cc, w); }
                    else { u32x4 w; w.x = cvt_pk_bf16(y[0], y[1]); w.y = cvt_pk_bf16(y[2], y[3]); w.z = cvt_pk_bf16(y[4], y[5]); w.w = cvt_pk_bf16(y[6], y[7]);
                        gst<u32x4>(KA + (size_t)row * 128 + hh * 64 + 8 * cc, w);
                        if (ctx) { float* o = out + OUT_K + srow * 128 + hh * 64 + 8 * cc; gst<f32x4>(o, (f32x4){y[0], y[1], y[2], y[3]}); gst<f32x4>(o + 4, (f32x4){y[4], y[5], y[6], y[7]}); } }
                }
            }
            if (ctx && lane >= 16 && lane < 32) {
                const int c = (lane - 16) * 8; const bf16x8 v = *(const LAS bf16x8*)(wrow + (640 + c) * 2); float* o = out + OUT_V + srow * 128 + c;
                gst<f32x4>(o, (f32x4){bf2f((bf16_t)v[0]), bf2f((bf16_t)v[1]), bf2f((bf16_t)v[2]), bf2f((bf16_t)v[3])}); gst<f32x4>(o + 4, (f32x4){bf2f((bf16_t)v[4]), bf2f((bf16_t)v[5]), bf2f((bf16_t)v[6]), bf2f((bf16_t)v[7])}); }
            {
                const bool isq = lane < 24, isk = lane >= 32 && lane < 48; const int c = isq ? 1024 + lane * 8 : 1216 + (lane - 32) * 8;
                float v[8]; float ss = 0.f;
                if (isq || isk) { const bf16x8 x = *(const LAS bf16x8*)(wrow + c * 2);
#pragma unroll
                    for (int e = 0; e < 8; ++e) { v[e] = bf2f((bf16_t)x[e]); ss += v[e] * v[e]; } }
                else {
#pragma unroll
                    for (int e = 0; e < 8; ++e) v[e] = 0.f; }
                const float sq = wave_sum(isq ? ss : 0.f), sk = wave_sum(isk ? ss : 0.f);
                const float rq = rsqrtf(sq * (1.f / 192.f) + EPSN), rk = rsqrtf(sk * (1.f / 128.f) + EPSN);
                if (lane < 32) { u32x4 w; w.x = cvt_pk_bf16(v[0] * rq, v[1] * rq); w.y = cvt_pk_bf16(v[2] * rq, v[3] * rq); w.z = cvt_pk_bf16(v[4] * rq, v[5] * rq); w.w = cvt_pk_bf16(v[6] * rq, v[7] * rq);
                    gst<u32x4>(CQN + (size_t)row * 256 + lane * 8, w); }
                if (isk) { const int cc = (lane - 32) * 8; const float* gk = INP(I_GCKV) + l * 128 + cc; const f32x4 g0 = gld<f32x4>(gk), g1 = gld<f32x4>(gk + 4);
                    float y[8];
#pragma unroll
                    for (int e = 0; e < 8; ++e) y[e] = v[e] * rk * (e < 4 ? g0[e & 3] : g1[e & 3]);
                    u32x4 w; w.x = cvt_pk_bf16(y[0], y[1]); w.y = cvt_pk_bf16(y[2], y[3]); w.z = cvt_pk_bf16(y[4], y[5]); w.w = cvt_pk_bf16(y[6], y[7]);
                    gst<u32x4>(CKVN + (size_t)row * 128 + cc, w);
                    if (ctx) { float* o = out + OUT_CKV + srow * 128 + cc; gst<f32x4>(o, (f32x4){y[0], y[1], y[2], y[3]}); gst<f32x4>(o + 4, (f32x4){y[4], y[5], y[6], y[7]}); } }
            }
            if (lane >= 48 && lane < 52) {
                const int cc = lane - 48; const bf16x8 own = *(const LAS bf16x8*)(wrow + (1344 + 8 * cc) * 2), oth = *(const LAS bf16x8*)(wrow + (1344 + 8 * (cc ^ 1)) * 2);
                const int pc = (cc & 2) ? pcc : prr; const LAS float* cp = tcC + pc * 8; const LAS float* sp = tsC + pc * 8;
                float y[8];
#pragma unroll
                for (int e = 0; e < 8; ++e) { const float xo = bf2f((bf16_t)own[e]), xp = bf2f((bf16_t)oth[e]);
                    y[e] = ctx ? xo : ((cc & 1) ? xo * cp[e] + xp * sp[e] : xo * cp[e] - xp * sp[e]); }
                u32x4 w; w.x = cvt_pk_bf16(y[0], y[1]); w.y = cvt_pk_bf16(y[2], y[3]); w.z = cvt_pk_bf16(y[4], y[5]); w.w = cvt_pk_bf16(y[6], y[7]);
                gst<u32x4>(KR + (size_t)row * 32 + 8 * cc, w);
                if (ctx) { float* o = out + OUT_KR + srow * 32 + 8 * cc; gst<f32x4>(o, (f32x4){y[0], y[1], y[2], y[3]}); gst<f32x4>(o + 4, (f32x4){y[4], y[5], y[6], y[7]}); } }
            LDS_WAIT(); asm volatile("" ::: "memory");
        }
        {
            constexpr int TP = 784;
            for (int tile = bx; tile < NTOK / 64; tile += G) {
                __syncthreads();
                const int t0 = tile * 64;
#pragma unroll
                for (int e = 0; e < 6; ++e) { const int ch = tid + 512 * e, r = ch / 48, c16 = ch % 48;
                    *(LAS u32x4*)(lds + r * TP + c16 * 16) = *(const u32x4*)(PROJ + (size_t)(t0 + r) * NPROJ + 640 + c16 * 8); }
                __syncthreads();
#pragma unroll
                for (int e = 0; e < 6; ++e) { const int it = tid + 512 * e, col = it % 384, tc = it / 384;
                    unsigned short v8[8];
#pragma unroll
                    for (int k = 0; k < 8; ++k) v8[k] = *(const LAS unsigned short*)(lds + (tc * 8 + k) * TP + col * 2);
                    u32x4 w; w.x = v8[0] | ((unsigned)v8[1] << 16); w.y = v8[2] | ((unsigned)v8[3] << 16); w.z = v8[4] | ((unsigned)v8[5] << 16); w.w = v8[6] | ((unsigned)v8[7] << 16);
                    *(u32x4*)(XT + (size_t)col * TOKP + t0 + tc * 8) = w; }
            }
            __syncthreads();
        }
        PH_END
        for (int rep_ = 0; rep_ < REP_P4; ++rep_)
        PH_BEGIN_L
        {
            LAS bf16_t* tc = (LAS bf16_t*)lds; LAS bf16_t* ts = tc + 4096;
            for (int i = tid; i < 4096; i += 512) { tc[i] = TABC[i]; ts[i] = TABS[i]; }
            __syncthreads();
            for (int q = gt; q < 8192 * 256; q += GT) { const int rq = q >> 8, row = (rq & ~255) | ((rq + 17 * (rq >> 8)) & 255), n0 = (q & 255) * 8, cs = row >> 12, kp = row & 4095; const LAS bf16_t* tb = cs ? ts : tc;
                unsigned short v8[8];
#pragma unroll
                for (int k = 0; k < 8; ++k) v8[k] = tb[(kp * (n0 + k)) & 4095];
                u32x4 w; w.x = v8[0] | ((unsigned)v8[1] << 16); w.y = v8[2] | ((unsigned)v8[3] << 16); w.z = v8[4] | ((unsigned)v8[5] << 16); w.w = v8[6] | ((unsigned)v8[7] << 16);
                gst<u32x4>(DFT + (size_t)row * 2048 + n0, w); }
            {
                bf16_t* XE = (bf16_t*)(ws + WS_XE); bf16_t* XO = (bf16_t*)(ws + WS_XO); float* XH = (float*)(ws + WS_XH);
                for (int q = gt; q < 1024 * 256; q += GT) { const int r = q >> 8, n0 = (q & 255) * 8, b = r >> 8, ch = r & 255;
                    const bf16_t* xrow = XT + (size_t)(128 + ch) * TOKP + NCTX + 4096 * b;
                    const bf16x8 x0 = gld<bf16x8>(xrow + n0), xa = gld<bf16x8>(xrow + 4096 - n0 - 8);
                    const bf16_t xb0 = n0 ? gld<bf16_t>(xrow + 4096 - n0) : (bf16_t)0;
                    float e8[8], o8[8];
#pragma unroll
                    for (int e = 0; e < 8; ++e) { const float xv = bf2f((bf16_t)x0[e]); const float pv = e == 0 ? bf2f(xb0) : bf2f((bf16_t)xa[8 - e]); e8[e] = xv + pv; o8[e] = xv - pv; }
                    if (n0 == 0) { o8[0] = 0.f; XH[r] = bf2f(gld<bf16_t>(xrow + 2048)); }
                    u32x4 we, wo; we.x = cvt_pk_bf16(e8[0], e8[1]); we.y = cvt_pk_bf16(e8[2], e8[3]); we.z = cvt_pk_bf16(e8[4], e8[5]); we.w = cvt_pk_bf16(e8[6], e8[7]);
                    wo.x = cvt_pk_bf16(o8[0], o8[1]); wo.y = cvt_pk_bf16(o8[2], o8[3]); wo.z = cvt_pk_bf16(o8[4], o8[5]); wo.w = cvt_pk_bf16(o8[6], o8[7]);
                    gst<u32x4>(XE + (size_t)r * 2048 + n0, we); gst<u32x4>(XO + (size_t)r * 2048 + n0, wo); }
            }
            __syncthreads();
            { pg8::Gemm g{CQN, (const bf16_t*)(wl + WO_UQ), 256, 256, 256, 256u * 256 * 2, 256u * 256 * 2}; pg8::StaticOrder S; S.init(80, 2, G, bx, 4);
              pg8::EpiStore E{QC, 384, 384, 1.f}; pg8::gemm_phase(lds, g, S, E); }
            { pg8::Gemm g{CKVN, (const bf16_t*)(wl + WO_WK), 128, 128, 128, 256u * 128 * 2, 256u * 128 * 2}; pg8::StaticOrder S; S.init(84, 1, G, (bx + 96) & 255, 2);
              pg8::EpiStore E{KC, 256, 256, 1.f}; pg8::gemm_phase(lds, g, S, E); }
            { pg8::Gemm g{(const bf16_t*)(wl + WO_WV), CKVN, 128, 128, 128, 256u * 128 * 2, 256u * 128 * 2}; pg8::StaticOrder S; S.init(1, 84, G, (bx + 12) & 255, 2);
              pg8::EpiStore E{VT, TOKP, TOKP, 1.f}; pg8::gemm_phase(lds, g, S, E); }
        }
        PH_END
        for (int rep_ = 0; rep_ < REP_P5; ++rep_)
        PH_BEGIN_L
        {
            const float* sinkl = INP(I_SINK) + l * 8;
            {
                const int b = vcu >> 6, h = (vcu >> 4) & 3, qb = vcu & 15; const int r0 = NCTX + 4096 * b + 256 * qb;
                FaArgs a; a.q = QC + (size_t)r0 * 384 + h * 96; a.q_pitch = 384; a.kn = KC + h * 64; a.kn_pitch = 256; a.kr = KR; a.kr_pitch = 32; a.vt = VT + (size_t)(h * 64) * TOKP; a.vt_pitch = TOKP;
                a.tok0 = NCTX + 4096 * b; a.nt0 = 64; a.tok1 = NTOK + 256 * b; a.nt1 = 4; a.j0 = 0; a.qpos0 = 256 * qb; a.sink2 = 0.f; a.has_sink = 0;
                a.o = MIX + (size_t)r0 * MIXW + 1024 + h * 64; a.o_pitch = MIXW; a.cosT = cosC; a.sinT = sinC;
                fa_unit<96, false, true>(lds, a);
            }
            __syncthreads();
            {
                const int f = vcu >> 1; pg8::OneUnit S{(vcu & 1) == 0, f >> 2, f & 3, 32};
                pg8::Gemm g{DFT, (const bf16_t*)(ws + ((f >> 2) >= 16 ? WS_XO : WS_XE)), 2048, 2048, 2048, 256u * 2048 * 2, 256u * 2048 * 2};
                pg8::EpiF1 E{MIX, 0, 1.f / 512.f, (const float*)(ws + WS_XH)}; pg8::gemm_phase(lds, g, S, E);
            }
            {
                const int nA = (vcu & 1) ? 3 : 1;
                for (int k = 0; k < nA; ++k) {
                    const int idx = (vcu & 1) ? (vcu >> 1) * 3 + k : 384 + (vcu >> 1);
                    const int b = idx >> 7, hq = (idx >> 4) & 7, qb = idx & 15, kvh = hq >> 2; const int q0 = 256 * qb, r0 = NCTX + 4096 * b + q0;
                    const int jlo = q0 - 128 < 0 ? 0 : q0 - 128, jhi = q0 + 384 > 4096 ? 4096 : q0 + 384;
                    FaArgs a; a.q = QA + (size_t)r0 * 512 + hq * 64; a.q_pitch = 512; a.kn = KA + kvh * 64; a.kn_pitch = 128; a.kr = nullptr; a.kr_pitch = 0; a.vt = XT + (size_t)(kvh * 64) * TOKP; a.vt_pitch = TOKP;
                    a.tok0 = NCTX + 4096 * b + jlo; a.nt0 = (jhi - jlo) >> 6; a.tok1 = NTOK + 256 * b; a.nt1 = 4; a.j0 = jlo; a.qpos0 = q0; a.sink2 = sinkl[hq] * LOG2E; a.has_sink = 1;
                    a.o = MIX + (size_t)r0 * MIXW + hq * 64; a.o_pitch = MIXW; a.cosT = nullptr; a.sinT = nullptr;
                    fa_unit<64, true, false>(lds, a);
                }
            }
            {
                for (int k = 0; k < 1; ++k) {
                    const int j = vcu; if (j >= 224) break;
                    if (j < 128) { const int s = j >> 3, hq = j & 7, kvh = hq >> 2; const int r0 = 256 * s;
                        FaArgs a; a.q = QA + (size_t)r0 * 512 + hq * 64; a.q_pitch = 512; a.kn = KA + kvh * 64; a.kn_pitch = 128; a.kr = nullptr; a.kr_pitch = 0; a.vt = XT + (size_t)(kvh * 64) * TOKP; a.vt_pitch = TOKP;
                        a.tok0 = r0; a.nt0 = 4; a.tok1 = 0; a.nt1 = 0; a.j0 = 0; a.qpos0 = 0; a.sink2 = sinkl[hq] * LOG2E; a.has_sink = 1;
                        a.o = MIX + (size_t)r0 * MIXW + hq * 64; a.o_pitch = MIXW; a.cosT = nullptr; a.sinT = nullptr;
                        fa_unit<64, false, false>(lds, a);
                    } else if (j < 192) { const int jj = j - 128, s = jj >> 2, h = jj & 3; const int r0 = 256 * s;
                        FaArgs a; a.q = QC + (size_t)r0 * 384 + h * 96; a.q_pitch = 384; a.kn = KC + h * 64; a.kn_pitch = 256; a.kr = KR; a.kr_pitch = 32; a.vt = VT + (size_t)(h * 64) * TOKP; a.vt_pitch = TOKP;
                        a.tok0 = r0; a.nt0 = 4; a.tok1 = 0; a.nt1 = 0; a.j0 = 0; a.qpos0 = 0; a.sink2 = 0.f; a.has_sink = 0;
                        a.o = MIX + (size_t)r0 * MIXW + 1024 + h * 64; a.o_pitch = MIXW; a.cosT = nullptr; a.sinT = nullptr;
                        fa_unit<96, false, false>(lds, a);
                    } else { const int jj = j - 192; __syncthreads();
                        pg8::OneUnit S{1, jj & 1, jj >> 1, 4};
                        pg8::Gemm g{DFT256, XT + (size_t)128 * TOKP, 256, TOKP, 256, 256u * 256 * 2, (size_t)256 * 2};
                        pg8::EpiF1 E{MIX, 1, 1.f / 128.f, nullptr}; pg8::gemm_phase(lds, g, S, E);
                    }
                }
            }
        }
        PH_END
        PH_BEGIN_L
        { pg8::Gemm g{MIX, (const bf16_t*)(wl + WO_OUT), MIXW, MIXW, MIXW, 256u * MIXW * 2, 256u * MIXW * 2}; pg8::SplitOrder S{vcu, 20, 6};
          pg8::EpiResid E{l == 0 ? INP(I_XP) : out, l == 0 ? INP(I_XS) : out + (size_t)NCTX * DM, out, modl + 2048, (float*)(ws + WS_R), (float*)(ws + WS_R + 24 * MiB)}; pg8::gemm_phase<true>(lds, g, S, E); }
        PH_END
        PH_BEGIN_L
        f32x4 nv[4], nw[4];
#pragma unroll
        for (int j = 0; j < 4; ++j) { nv[j] = gld<f32x4>(out + (size_t)gw * DM + 4 * lane + 256 * j); nw[j] = gld<f32x4>(out + (size_t)(gw + NGW) * DM + 4 * lane + 256 * j); }
        for (int row = gw; row < NTOK; row += NGW) {
            const int mi = row < NCTX ? 0 : 1 + ((row - NCTX) >> 12);
            const float* sh = modl + mi * 6144 + 3072, *sc = sh + 1024; const float* gm = INP(I_GFFN) + l * DM;
            f32x4 v[4]; float s = 0.f;
#pragma unroll
            for (int j = 0; j < 4; ++j) { v[j] = nv[j]; nv[j] = nw[j]; }
            { const int nr = row + 2 * NGW < NTOK ? row + 2 * NGW : row;
#pragma unroll
                for (int j = 0; j < 4; ++j) nw[j] = gld<f32x4>(out + (size_t)nr * DM + 4 * lane + 256 * j); }
#pragma unroll
            for (int j = 0; j < 4; ++j) {
                if (row >= 16384) { const size_t po = (size_t)(row - 16384) * DM + 4 * lane + 256 * j; const bf16_t* pa = (const bf16_t*)(ws + WS_R);
                    const f32x4 ps = (ld_bf4(pa + po) + ld_bf4(pa + 4194304 + po)) + (ld_bf4(pa + 2 * 4194304 + po) + ld_bf4(pa + 3 * 4194304 + po));
                    v[j] += *(const f32x4*)(modl + 4 * 6144 + 2048 + 4 * lane + 256 * j) * ps; *(f32x4*)(out + (size_t)row * DM + 4 * lane + 256 * j) = v[j]; }
                s += v[j][0] * v[j][0] + v[j][1] * v[j][1] + v[j][2] * v[j][2] + v[j][3] * v[j][3]; }
            const float rstd = rsqrtf(wave_sum(s) * (1.f / DM) + EPSN);
#pragma unroll
            for (int j = 0; j < 4; ++j) { const int c = 4 * lane + 256 * j; const f32x4 g4 = *(const f32x4*)(gm + c), s4 = *(const f32x4*)(sc + c), h4 = *(const f32x4*)(sh + c);
                const f32x4 y = v[j] * rstd * g4 * (s4 + 1.f) + h4;
                u32x2 w; w.x = cvt_pk_bf16(y[0], y[1]); w.y = cvt_pk_bf16(y[2], y[3]); *(u32x2*)(H + (size_t)row * DM + c) = w; }
        }
        PH_END
        for (int rep_ = 0; rep_ < REP_P8; ++rep_)
        PH_BEGIN_L
        { pg8::Gemm g{H, (const bf16_t*)(wl + WO_UG), 1024, 1024, 1024, 256u * 1024 * 2, 256u * 1024 * 2}; pg8::StaticOrder S; S.init(80, 22, G, bx, 16);
          pg8::EpiConv E{ACT, EDGE, INP(I_CONVW) + (size_t)l * 3 * 5632, INP(I_CONVB) + (size_t)l * 5632}; pg8::gemm_phase(lds, g, S, E); }
        PH_END
        PH_BEGIN_L
        {
            const float* cw = INP(I_CONVW) + (size_t)l * 3 * 5632; const float* cb = INP(I_CONVB) + (size_t)l * 5632;
            for (int idx = gt; idx < 60 * DFF; idx += GT) { const int bnd = idx / DFF, j = idx % DFF; const int pm = 16 + (bnd / 15) * 16 + (bnd % 15);
                const float* e0 = EDGE + ((size_t)pm * 4 + 2) * 5632, *e1 = e0 + 5632, *e2 = EDGE + ((size_t)(pm + 1) * 4) * 5632, *e3 = e2 + 5632;
                const float wa0 = cw[j], wa1 = cw[5632 + j], wa2 = cw[2 * 5632 + j], ba = cb[j], wg0 = cw[DFF + j], wg1 = cw[5632 + DFF + j], wg2 = cw[2 * 5632 + DFF + j], bg = cb[DFF + j];
                { const float ua = e0[j] * wa0 + e1[j] * wa1 + e2[j] * wa2 + ba, ug = e0[DFF + j] * wg0 + e1[DFF + j] * wg1 + e2[DFF + j] * wg2 + bg;
                  ACT[(size_t)(pm * 256 + 255) * DFF + j] = f2bf(ua * ug / (1.f + __expf(-ug))); }
                { const float ua = e1[j] * wa0 + e2[j] * wa1 + e3[j] * wa2 + ba, ug = e1[DFF + j] * wg0 + e2[DFF + j] * wg1 + e3[DFF + j] * wg2 + bg;
                  ACT[(size_t)(pm * 256 + 256) * DFF + j] = f2bf(ua * ug / (1.f + __expf(-ug))); }
            }
        }
        PH_END
        PH_BEGIN_L
        { pg8::Gemm g{ACT, (const bf16_t*)(wl + WO_DN), DFF, DFF, DFF, 256u * DFF * 2, 256u * DFF * 2}; pg8::SplitOrder S{vcu, 44, 12};
          pg8::EpiResid E{out, out + (size_t)NCTX * DM, out, modl + 5120, (float*)(ws + 207 * MiB), (float*)wl}; pg8::gemm_phase<true>(lds, g, S, E); }
        PH_END
    }
    PH_BEGIN
    f32x4 nv[4], nw[4];
#pragma unroll
    for (int j = 0; j < 4; ++j) { nv[j] = gld<f32x4>(out + (size_t)gw * DM + 4 * lane + 256 * j); nw[j] = gld<f32x4>(out + (size_t)(gw + NGW) * DM + 4 * lane + 256 * j); }
    for (int row = gw; row < NTOK; row += NGW) {
        float* xr = out + (size_t)row * DM; const float* gm = INP(I_GFINAL);
        f32x4 v[4]; float s = 0.f;
#pragma unroll
        for (int j = 0; j < 4; ++j) { v[j] = nv[j]; nv[j] = nw[j]; }
        { const int nr = row + 2 * NGW < NTOK ? row + 2 * NGW : row;
#pragma unroll
            for (int j = 0; j < 4; ++j) nw[j] = gld<f32x4>(out + (size_t)nr * DM + 4 * lane + 256 * j); }
#pragma unroll
        for (int j = 0; j < 4; ++j) {
            if (row >= 16384) { const size_t po = (size_t)(row - 16384) * DM + 4 * lane + 256 * j; const bf16_t* pa = (const bf16_t*)(ws + 207 * MiB); const bf16_t* pb = (const bf16_t*)(ws + WS_W + W_LSTRIDE);
                const f32x4 ps = (ld_bf4(pa + po) + ld_bf4(pa + 4194304 + po)) + (ld_bf4(pa + 2 * 4194304 + po) + ld_bf4(pb + po));
                v[j] += *(const f32x4*)(MOD + 5 * 6144 + 4 * 6144 + 5120 + 4 * lane + 256 * j) * ps; }
            s += v[j][0] * v[j][0] + v[j][1] * v[j][1] + v[j][2] * v[j][2] + v[j][3] * v[j][3]; }
        const float rstd = rsqrtf(wave_sum(s) * (1.f / DM) + EPSN);
#pragma unroll
        for (int j = 0; j < 4; ++j) { const int c = 4 * lane + 256 * j; *(f32x4*)(xr + c) = v[j] * rstd * *(const f32x4*)(gm + c); }
    }
    }
#undef PH_BEGIN
#undef PH_END
}

extern "C" void kernel_launch(void* const* d_in, const int* in_sizes, int n_in, void* d_out, int out_size, void* d_ws, size_t ws_size, hipStream_t stream) {
    static int grid = 0;
    if (grid == 0) {
        int dev = 0, cus = 0, per_cu = 0;
        (void)hipGetDevice(&dev);
        (void)hipDeviceGetAttribute(&cus, hipDeviceAttributeMultiprocessorCount, dev);
        (void)hipFuncSetAttribute((const void*)mk_fwd, hipFuncAttributeMaxDynamicSharedMemorySize, LDS_BYTES);
        (void)hipOccupancyMaxActiveBlocksPerMultiprocessor(&per_cu, (const void*)mk_fwd, 512, LDS_BYTES);
        grid = (per_cu >= 1 && cus == 256) ? cus : -1;
        if (n_in != 24 || ws_size < 256 * MiB) { fprintf(stderr, "kernel_launch: unexpected n_in %d / ws %zu\n", n_in, ws_size); grid = -1; }
        if (grid < 0) fprintf(stderr, "kernel_launch: cannot launch (per_cu %d)\n", per_cu);
    }
    if (grid < 0) return;
    (void)hipMemsetAsync(d_ws, 0, 16384, stream);
    Args a{};
    for (int i = 0; i < 24; ++i) a.in[i] = (const float*)d_in[i];
    a.out = (float*)d_out; a.ws = (unsigned char*)d_ws; a.use_cg = 0; a.pad = 0;
    void* kargs[] = {&a};
    hipError_t e = hipLaunchCooperativeKernel((const void*)mk_fwd, dim3(grid), dim3(512), kargs, LDS_BYTES, stream);
    if (e != hipSuccess) fprintf(stderr, "cooperative launch failed: %s (grid %d)\n", hipGetErrorString(e), grid);
}
```

```cpp
#include <hip/hip_runtime.h>
#include <hip/hip_cooperative_groups.h>
#include <cstdio>
#include <cstdint>
namespace cg = cooperative_groups;

#define LAS __attribute__((address_space(3)))
typedef unsigned short bf16_t;
typedef short bf16x8 __attribute__((ext_vector_type(8)));
typedef short s16x4 __attribute__((ext_vector_type(4)));
typedef float f32x4 __attribute__((ext_vector_type(4)));
typedef float f32x16 __attribute__((ext_vector_type(16)));
typedef unsigned u32x4 __attribute__((ext_vector_type(4)));
typedef unsigned u32x2 __attribute__((ext_vector_type(2)));

constexpr int NTOK = 20480, NCTX = 4096, TOKP = 21504, DM = 1024, NPROJ = 1536, DFF = 2816, MIXW = 1280;
constexpr float EPSN = 1e-6f;
constexpr float LOG2E = 1.4426950408889634f;
constexpr float QS_A = 0.125f * LOG2E;
constexpr float QS_C = 0.10206207261596575f * LOG2E;
constexpr size_t OUT_K = (size_t)NTOK * DM, OUT_V = OUT_K + 1048576, OUT_CKV = OUT_V + 1048576, OUT_KR = OUT_CKV + 1048576;
constexpr size_t MiB = 1u << 20;
constexpr size_t WS_W = 1 * MiB, W_LSTRIDE = 22 * MiB + 512 * 1024;
constexpr size_t WO_IN = 0, WO_OUT = 3 * MiB, WO_UG = 5 * MiB + 512 * 1024, WO_DN = 16 * MiB + 512 * 1024, WO_UQ = 22 * MiB, WO_WK = 22 * MiB + 256 * 1024, WO_WV = 22 * MiB + 320 * 1024;
constexpr size_t WS_MOD = 46 * MiB, WS_TAB = 46 * MiB + 256 * 1024, WS_DFT256 = 46 * MiB + 512 * 1024;
constexpr size_t WS_H = 47 * MiB;
constexpr size_t WS_R = 97 * MiB;
constexpr size_t WS_PROJ = WS_R, WS_DFT = WS_R;
constexpr size_t WS_QA = 161 * MiB, WS_KA = 181 * MiB, WS_CQN = 186 * MiB + 256 * 1024, WS_CKVN = 196 * MiB + 256 * 1024;
constexpr size_t WS_QC = 201 * MiB + 512 * 1024, WS_KC = 216 * MiB + 512 * 1024, WS_VT = 227 * MiB, WS_KR = 237 * MiB + 512 * 1024, WS_XT = 239 * MiB;
constexpr size_t WS_ACT = WS_R, WS_EDGE = 207 * MiB;
constexpr size_t WS_XE = 129 * MiB, WS_XO = 133 * MiB, WS_XH = 137 * MiB;
constexpr size_t T_COSA = 0, T_SINA = 4096, T_COSC = 8192, T_SINC = 10240, T_TABC = 12288, T_TABS = 20480;
constexpr int RING_BYTES = 131072, E_OFF = RING_BYTES + 1024, LDS_BYTES = 147456;

typedef float f32x2_t __attribute__((ext_vector_type(2))); typedef __bf16 bf16x2_t __attribute__((ext_vector_type(2)));
__device__ __forceinline__ unsigned cvt_pk_bf16(float lo, float hi) { f32x2_t v = {lo, hi}; bf16x2_t b = __builtin_convertvector(v, bf16x2_t); return __builtin_bit_cast(unsigned, b); }
__device__ __forceinline__ bf16_t f2bf(float f) { return (bf16_t)(cvt_pk_bf16(f, 0.f) & 0xffffu); }
__device__ __forceinline__ float bf2f(bf16_t b) { return __uint_as_float((unsigned)b << 16); }
__device__ __forceinline__ float wave_sum(float v) {
#pragma unroll
    for (int o = 1; o < 64; o <<= 1) v += __shfl_xor(v, o);
    return v;
}
#define LDS_WAIT() asm volatile("s_waitcnt lgkmcnt(0)" ::: "memory")
#define GAS __attribute__((address_space(1)))
template <class T> __device__ __forceinline__ T gld(const void* p) { return *(const GAS T*)p; }
template <class T> __device__ __forceinline__ void gst(void* p, T v) { *(GAS T*)p = v; }

namespace pg8 {
constexpr int BM = 256, BK = 64, HALF = 128, HTB = HALF * BK * 2, STAGE_BYTES = 8 * HTB, NXCD = 8, WGM = 8;
__host__ __device__ __forceinline__ int lds_byte(int r, int c) { const int st = (r >> 4) * 2 + (c >> 5), rr = r & 15, cc = c & 31, ob = rr * 64 + cc * 2; return st * 1024 + (ob ^ (((ob >> 9) & 1) << 5)); }
__host__ __device__ __forceinline__ void stage_rc(int b, int& R, int& C) { const int st = b / 1024, sb = b % 1024, swz = sb ^ (((sb >> 9) & 1) << 5); R = (st >> 1) * 16 + swz / 64; C = (st & 1) * 32 + (swz % 64) / 2; }
__host__ __device__ __forceinline__ int perm32(int rho) { const int n = rho >> 4, i = rho & 15; return 8 * (i >> 2) + 4 * n + (i & 3); }
struct Unit { int pm, pn, kt0, nt, part; };
struct Gemm { const bf16_t* A; const bf16_t* Bt; int lda, ldb, K; unsigned tsA, tsB; };
struct StaticOrder {
    int nM, nN, nwg, G, c, ntk;
    __device__ void init(int nM_, int nN_, int G_, int c_, int ntk_) { nM = nM_; nN = nN_; nwg = nM * nN; G = G_; c = c_; ntk = ntk_; }
    __device__ bool next(int i, Unit& u) const {
        const long L = (long)i * G + c; if (L >= nwg) return false;
        int wgid = (int)L; { const int q = nwg / NXCD, r = nwg % NXCD, xcd = wgid % NXCD, off = wgid / NXCD; wgid = (xcd < r ? xcd * (q + 1) : r * (q + 1) + (xcd - r) * q) + off; }
        const int nig = WGM * nN, gid = wgid / nig, fm = gid * WGM, gsz = (nM - fm) < WGM ? (nM - fm) : WGM;
        u.pm = fm + ((wgid % nig) % gsz); u.pn = (wgid % nig) / gsz; u.kt0 = 0; u.nt = ntk; u.part = -1; return true;
    }
};
struct SplitOrder { int vcu, ntk, a;
    __device__ bool next(int i, Unit& u) const {
        if (i == 0) { u.pm = vcu >> 2; u.pn = vcu & 3; u.kt0 = 0; u.nt = ntk; u.part = -1; return true; }
        if (i == 1) { const int u64 = vcu >> 2, part = vcu & 3; u.pm = 64 + (u64 >> 2); u.pn = u64 & 3;
            const int over = part > 2 ? part - 2 : 0;
            u.kt0 = a * part - 2 * over; u.nt = part < 2 ? a : a - 2; u.part = part; return true; }
        return false; } };
struct OneUnit { int has, pm, pn, ntk; __device__ bool next(int i, Unit& u) const { if (i > 0 || !has) return false; u.pm = pm; u.pn = pn; u.kt0 = 0; u.nt = ntk; u.part = -1; return true; } };

template <bool SPLIT = false, class Epi, class Sched>
__device__ __forceinline__ void gemm_phase(LAS unsigned char* lds, const Gemm g, const Sched& S, const Epi& E) {
    int tid_ = threadIdx.x; asm volatile("" : "+v"(tid_));
    const int tid = tid_, wid = __builtin_amdgcn_readfirstlane(tid >> 6), lane = tid & 63, wr = wid >> 2, wc = wid & 3, fr = lane & 15, fq = lane >> 4;
    unsigned voffA[2], voffB[2];
#pragma unroll
    for (int i = 0; i < 2; ++i) { int R, C; stage_rc(tid * 16 + i * 8192, R, C); const int Rb = Epi::PERM ? ((R & ~31) + perm32(R & 31)) : R;
        voffA[i] = (unsigned)(R * g.lda + C) * 2u; voffB[i] = (unsigned)(Rb * g.ldb + C) * 2u; }
    const size_t kstep = (size_t)(BK * 2);
    const size_t hstepA = (size_t)HALF * g.lda * 2, hstepB = (size_t)HALF * g.ldb * 2;
    const unsigned ldsw = (unsigned)wid * 1024u;
    const int aoff = lds_byte(wr * 64 + fr, fq * 8), boff = lds_byte(wc * 32 + fr, fq * 8);
#define PG8_SA(b, h) (((b) * 2 + (h)) * HTB)
#define PG8_SB(b, h) ((4 + (b) * 2 + (h)) * HTB)
#define PG8_STAGE(bufoff, gbase, voff) do { _Pragma("unroll") for (int _i = 0; _i < 2; ++_i) \
        __builtin_amdgcn_global_load_lds((const unsigned*)((const char*)(gbase) + (voff)[_i]), (LAS unsigned*)(lds + (bufoff) + ldsw + _i * 8192), 16, 0, 0); } while (0)
#define PG8_LDA(dst, b, h) do { _Pragma("unroll") for (int m = 0; m < 4; ++m) _Pragma("unroll") for (int k = 0; k < 2; ++k) dst[m][k] = *(const LAS bf16x8*)(lds + PG8_SA(b, h) + aoff + m * 2048 + k * 1024); } while (0)
#define PG8_LDB(dst, b, h) do { _Pragma("unroll") for (int n = 0; n < 2; ++n) _Pragma("unroll") for (int k = 0; k < 2; ++k) dst[n][k] = *(const LAS bf16x8*)(lds + PG8_SB(b, h) + boff + n * 2048 + k * 1024); } while (0)
#define PG8_MMA(ai, bj, At, Bt) do { __builtin_amdgcn_s_setprio(1); _Pragma("unroll") for (int m = 0; m < 4; ++m) _Pragma("unroll") for (int n = 0; n < 2; ++n) _Pragma("unroll") for (int k = 0; k < 2; ++k) \
        acc[ai][bj][m][n] = __builtin_amdgcn_mfma_f32_16x16x32_bf16(Bt[n][k], At[m][k], acc[ai][bj][m][n], 0, 0, 0); __builtin_amdgcn_s_setprio(0); } while (0)
#define PG8_WAIT_V(n) asm volatile("s_waitcnt vmcnt(" #n ")" ::: "memory")
#define PG8_WAIT_L(n) asm volatile("s_waitcnt lgkmcnt(" #n ")" ::: "memory")
#define PG8_BAR __builtin_amdgcn_s_barrier()
#define PG8_SCHED __builtin_amdgcn_sched_barrier(0)
    Unit cur, nxt; int ui = 0;
    if (!S.next(0, cur)) return;
    f32x4 acc[2][2][4][2];
#pragma unroll
    for (int a = 0; a < 2; ++a)
#pragma unroll
        for (int b = 0; b < 2; ++b)
#pragma unroll
            for (int m = 0; m < 4; ++m)
#pragma unroll
                for (int n = 0; n < 2; ++n) acc[a][b][m][n] = (f32x4){0.f, 0.f, 0.f, 0.f};
    bf16x8 At[4][2], B0[2][2], B1[2][2];
    const char* cA = (const char*)g.A + (size_t)cur.pm * g.tsA + (SPLIT ? (size_t)cur.kt0 * 128 : 0); const char* cB = (const char*)g.Bt + (size_t)cur.pn * g.tsB + (SPLIT ? (size_t)cur.kt0 * 128 : 0);
    const int ntk = g.K / BK;
    PG8_STAGE(PG8_SB(0, 0), cB, voffB); PG8_STAGE(PG8_SB(0, 1), cB + hstepB, voffB); PG8_STAGE(PG8_SA(0, 0), cA, voffA); PG8_STAGE(PG8_SA(0, 1), cA + hstepA, voffA);
    if (wr == 1) PG8_BAR;
    PG8_WAIT_V(2); PG8_BAR;
    PG8_STAGE(PG8_SB(1, 0), cB + kstep, voffB); PG8_STAGE(PG8_SA(1, 0), cA + kstep, voffA); PG8_STAGE(PG8_SB(1, 1), cB + hstepB + kstep, voffB);
    PG8_WAIT_V(6); PG8_BAR;
    for (;;) {
        const bool has_next = S.next(ui + 1, nxt);
        const char* nA = has_next ? (const char*)g.A + (size_t)nxt.pm * g.tsA + (SPLIT ? (size_t)nxt.kt0 * 128 : 0) : cA; const char* nB = has_next ? (const char*)g.Bt + (size_t)nxt.pn * g.tsB + (SPLIT ? (size_t)nxt.kt0 * 128 : 0) : cB;
        const int nt = SPLIT ? cur.nt : ntk;
        for (int t = 0; t < nt; t += 2) {
            const bool last = (t == nt - 2);
            const char* a1 = cA + (size_t)(t + 1) * kstep;
            const char* a2 = last ? nA : cA + (size_t)(t + 2) * kstep; const char* b2 = last ? nB : cB + (size_t)(t + 2) * kstep;
            const char* a3 = a2 + kstep; const char* b3 = b2 + kstep;
            PG8_LDB(B0, 0, 0); PG8_LDB(B1, 0, 1); PG8_SCHED; PG8_LDA(At, 0, 0); PG8_STAGE(PG8_SA(1, 1), a1 + hstepA, voffA);
            PG8_WAIT_V(8); PG8_WAIT_L(0); PG8_BAR; PG8_MMA(0, 0, At, B0); PG8_MMA(0, 1, At, B1); PG8_BAR; PG8_SCHED;
            PG8_LDA(At, 0, 1); PG8_STAGE(PG8_SB(0, 0), b2, voffB); PG8_STAGE(PG8_SB(0, 1), b2 + hstepB, voffB); PG8_STAGE(PG8_SA(0, 0), a2, voffA);
            PG8_WAIT_V(8); PG8_WAIT_L(0); PG8_BAR; PG8_MMA(1, 0, At, B0); PG8_MMA(1, 1, At, B1); PG8_BAR; PG8_SCHED;
            PG8_LDB(B0, 1, 0); PG8_LDB(B1, 1, 1); PG8_SCHED; PG8_LDA(At, 1, 0); PG8_STAGE(PG8_SA(0, 1), a2 + hstepA, voffA);
            PG8_WAIT_V(8); PG8_WAIT_L(0); PG8_BAR; PG8_MMA(0, 0, At, B0); PG8_MMA(0, 1, At, B1); PG8_BAR; PG8_SCHED;
            PG8_LDA(At, 1, 1); PG8_STAGE(PG8_SB(1, 0), b3, voffB); PG8_STAGE(PG8_SB(1, 1), b3 + hstepB, voffB); PG8_STAGE(PG8_SA(1, 0), a3, voffA);
            PG8_WAIT_V(8); PG8_WAIT_L(0); PG8_BAR; PG8_MMA(1, 0, At, B0); PG8_MMA(1, 1, At, B1); PG8_BAR; PG8_SCHED;
        }
        if (wr == 0) PG8_BAR;
        E(acc, cur, wr, wc, fr, fq, lds);
        if (!has_next) break;
#pragma unroll
        for (int a = 0; a < 2; ++a)
#pragma unroll
            for (int b = 0; b < 2; ++b)
#pragma unroll
                for (int m = 0; m < 4; ++m)
#pragma unroll
                    for (int n = 0; n < 2; ++n) acc[a][b][m][n] = (f32x4){0.f, 0.f, 0.f, 0.f};
        cur = nxt; cA = nA; cB = nB; ++ui;
        if (wr == 1) PG8_BAR;
    }
    PG8_WAIT_V(0);
    PG8_BAR;
#undef PG8_SA
#undef PG8_SB
#undef PG8_STAGE
#undef PG8_LDA
#undef PG8_LDB
#undef PG8_MMA
#undef PG8_WAIT_V
#undef PG8_WAIT_L
#undef PG8_BAR
#undef PG8_SCHED
}

struct EpiStore {
    static constexpr bool PERM = true;
    bf16_t* O; int ldc; int ncols; float scale;
    __device__ __forceinline__ void operator()(const f32x4 (&acc)[2][2][4][2], const Unit& u, int wr, int wc, int fr_, int fq_, LAS unsigned char*) const {
        int fr = fr_, fq = fq_; asm volatile("" : "+v"(fr), "+v"(fq));
        const int row0 = u.pm * BM + wr * 64 + fr, col0 = u.pn * BM + wc * 32 + 8 * fq;
#pragma unroll
        for (int ai = 0; ai < 2; ++ai)
#pragma unroll
            for (int m = 0; m < 4; ++m) { bf16_t* rowp = O + (size_t)(row0 + ai * HALF + m * 16) * ldc + col0;
#pragma unroll
                for (int bj = 0; bj < 2; ++bj) if (col0 + bj * HALF < ncols) { const f32x4 v0 = acc[ai][bj][m][0] * scale, v1 = acc[ai][bj][m][1] * scale;
                    u32x4 w; w.x = cvt_pk_bf16(v0[0], v0[1]); w.y = cvt_pk_bf16(v0[2], v0[3]); w.z = cvt_pk_bf16(v1[0], v1[1]); w.w = cvt_pk_bf16(v1[2], v1[3]);
                    gst<u32x4>(rowp + bj * HALF, w); } }
    }
};
struct EpiResid {
    static constexpr bool PERM = false;
    const float* xin0; const float* xin1; float* out; const float* gate; float* partA; float* partB;
    __device__ __forceinline__ void operator()(const f32x4 (&acc)[2][2][4][2], const Unit& u, int wr, int wc, int fr_, int fq_, LAS unsigned char*) const {
        int fr = fr_, fq = fq_; asm volatile("" : "+v"(fr), "+v"(fq));
        const int mi = u.pm < 16 ? 0 : 1 + ((u.pm - 16) >> 4);
        const float* gp = gate + mi * 6144;
        const float* xb = u.pm < 16 ? xin0 : xin1 - (size_t)NCTX * DM;
        const int row0 = u.pm * BM + wr * 64 + fr, col0 = u.pn * BM + wc * 32 + 4 * fq;
#pragma unroll
        for (int bj = 0; bj < 2; ++bj)
#pragma unroll
            for (int n = 0; n < 2; ++n) { const f32x4 gv = gld<f32x4>(gp + col0 + bj * HALF + n * 16);
#pragma unroll
                for (int ai = 0; ai < 2; ++ai)
#pragma unroll
                    for (int m = 0; m < 4; ++m) { const size_t off = (size_t)(row0 + ai * HALF + m * 16) * DM + col0 + bj * HALF + n * 16;
                        if (u.part < 0) { const f32x4 o = gld<f32x4>(xb + off) + gv * acc[ai][bj][m][n]; gst<f32x4>(out + off, o); }
                        else { bf16_t* pp = (u.part < 3 ? (bf16_t*)partA + (size_t)u.part * 4194304 : (bf16_t*)partB) + (off - (size_t)16384 * DM); const f32x4 a_ = acc[ai][bj][m][n];
                            gst<u32x2>(pp, (u32x2){cvt_pk_bf16(a_[0], a_[1]), cvt_pk_bf16(a_[2], a_[3])}); } } }
    }
};
struct EpiF1 {
    static constexpr bool PERM = true;
    bf16_t* MIXp; int ctx; float scale; const float* xh;
    __device__ __forceinline__ void operator()(const f32x4 (&acc)[2][2][4][2], const Unit& u, int wr, int wc, int fr_, int fq_, LAS unsigned char*) const {
        int fr = fr_, fq = fq_; asm volatile("" : "+v"(fr), "+v"(fq));
        int cs, tokbase;
        if (ctx) { cs = u.pm; tokbase = 256 * u.pn; } else { cs = u.pm >> 4; tokbase = NCTX + 4096 * u.pn + (u.pm & 15) * 256; }
#pragma unroll
        for (int ai = 0; ai < 2; ++ai)
#pragma unroll
            for (int m = 0; m < 4; ++m) { const int rowl = wr * 64 + fr + ai * HALF + m * 16;
#pragma unroll
                for (int bj = 0; bj < 2; ++bj) { const int ch = wc * 32 + 8 * fq + bj * HALF;
                    bf16_t* dst = MIXp + (size_t)(tokbase + rowl) * MIXW + 512 + (ch >> 6) * 128 + cs * 64 + (ch & 63);
                    f32x4 a0 = acc[ai][bj][m][0], a1 = acc[ai][bj][m][1];
                    if (!ctx && cs == 0) { const float sg = (rowl & 1) ? -1.f : 1.f; a0 += gld<f32x4>(xh + u.pn * 256 + ch) * sg; a1 += gld<f32x4>(xh + u.pn * 256 + ch + 4) * sg; }
                    const f32x4 v0 = a0 * scale, v1 = a1 * scale;
                    u32x4 w; w.x = cvt_pk_bf16(v0[0], v0[1]); w.y = cvt_pk_bf16(v0[2], v0[3]); w.z = cvt_pk_bf16(v1[0], v1[1]); w.w = cvt_pk_bf16(v1[2], v1[3]);
                    gst<u32x4>(dst, w); } }
    }
};
__device__ __forceinline__ float dpp_ror1(float v) { return __int_as_float(__builtin_amdgcn_mov_dpp(__float_as_int(v), 0x121, 0xf, 0xf, false)); }
__device__ __forceinline__ float dpp_rol1(float v) { return __int_as_float(__builtin_amdgcn_mov_dpp(__float_as_int(v), 0x12F, 0xf, 0xf, false)); }
struct EpiConv {
    static constexpr bool PERM = true;
    bf16_t* ACT; float* EDGE; const float* cw; const float* cb;
    __device__ __forceinline__ void operator()(const f32x4 (&acc)[2][2][4][2], const Unit& u, int wr, int wc, int fr_, int fq_, LAS unsigned char* lds) const {
        int fr = fr_, fq = fq_; asm volatile("" : "+v"(fr), "+v"(fq));
        LAS float* E = (LAS float*)(lds + E_OFF);
        const int pm = u.pm, pn = u.pn;
        const bool first = pm < 16 || ((pm - 16) & 15) == 0, last = pm < 16 || ((pm - 16) & 15) == 15;
        const int lc0 = wc * 32 + 8 * fq;
#pragma unroll
        for (int ai = 0; ai < 2; ++ai) { const int G = 2 * ai + wr;
            if (fr == 0) {
#pragma unroll
                for (int bj = 0; bj < 2; ++bj)
#pragma unroll
                    for (int n = 0; n < 2; ++n) *(LAS f32x4*)(E + (G * 2 + 0) * 256 + bj * 128 + lc0 + 4 * n) = acc[ai][bj][0][n]; }
            if (fr == 15) {
#pragma unroll
                for (int bj = 0; bj < 2; ++bj)
#pragma unroll
                    for (int n = 0; n < 2; ++n) *(LAS f32x4*)(E + (G * 2 + 1) * 256 + bj * 128 + lc0 + 4 * n) = acc[ai][bj][3][n]; }
        }
        if (wr == 0 && fr < 2) {
#pragma unroll
            for (int bj = 0; bj < 2; ++bj)
#pragma unroll
                for (int n = 0; n < 2; ++n) gst<f32x4>(EDGE + ((size_t)pm * 4 + fr) * 5632 + bj * DFF + pn * 128 + lc0 + 4 * n, acc[0][bj][0][n]); }
        if (wr == 1 && fr >= 14) {
#pragma unroll
            for (int bj = 0; bj < 2; ++bj)
#pragma unroll
                for (int n = 0; n < 2; ++n) gst<f32x4>(EDGE + ((size_t)pm * 4 + 2 + (fr - 14)) * 5632 + bj * DFF + pn * 128 + lc0 + 4 * n, acc[1][bj][3][n]); }
        asm volatile("s_waitcnt lgkmcnt(0)" ::: "memory"); __builtin_amdgcn_s_barrier(); asm volatile("" ::: "memory");
#pragma unroll
        for (int ai = 0; ai < 2; ++ai) { const int G = 2 * ai + wr;
#pragma unroll
            for (int n = 0; n < 2; ++n) { const int ca = pn * 128 + lc0 + 4 * n;
                f32x4 wA[3], wG[3];
#pragma unroll
                for (int t = 0; t < 3; ++t) { wA[t] = gld<f32x4>(cw + t * 5632 + ca); wG[t] = gld<f32x4>(cw + t * 5632 + DFF + ca); }
                const f32x4 bA = gld<f32x4>(cb + ca), bG = gld<f32x4>(cb + DFF + ca);
                const f32x4 z = {0.f, 0.f, 0.f, 0.f};
                const f32x4 ePa = G > 0 ? *(LAS f32x4*)(E + ((G - 1) * 2 + 1) * 256 + lc0 + 4 * n) : z, ePg = G > 0 ? *(LAS f32x4*)(E + ((G - 1) * 2 + 1) * 256 + 128 + lc0 + 4 * n) : z;
                const f32x4 eNa = G < 3 ? *(LAS f32x4*)(E + ((G + 1) * 2 + 0) * 256 + lc0 + 4 * n) : z, eNg = G < 3 ? *(LAS f32x4*)(E + ((G + 1) * 2 + 0) * 256 + 128 + lc0 + 4 * n) : z;
#pragma unroll
                for (int m = 0; m < 4; ++m) { float res[4];
#pragma unroll
                    for (int i = 0; i < 4; ++i) {
                        const float xa = acc[ai][0][m][n][i], xg = acc[ai][1][m][n][i];
                        const float sPa = (fr == 15 && m > 0) ? acc[ai][0][m > 0 ? m - 1 : 0][n][i] : xa, sPg = (fr == 15 && m > 0) ? acc[ai][1][m > 0 ? m - 1 : 0][n][i] : xg;
                        const float sNa = (fr == 0 && m < 3) ? acc[ai][0][m < 3 ? m + 1 : 3][n][i] : xa, sNg = (fr == 0 && m < 3) ? acc[ai][1][m < 3 ? m + 1 : 3][n][i] : xg;
                        float pa = dpp_ror1(sPa), pg = dpp_ror1(sPg), na = dpp_rol1(sNa), ng = dpp_rol1(sNg);
                        if (m == 0) { pa = fr == 0 ? ePa[i] : pa; pg = fr == 0 ? ePg[i] : pg; }
                        if (m == 3) { na = fr == 15 ? eNa[i] : na; ng = fr == 15 ? eNg[i] : ng; }
                        const float ua = pa * wA[0][i] + xa * wA[1][i] + na * wA[2][i] + bA[i];
                        const float ug = pg * wG[0][i] + xg * wG[1][i] + ng * wG[2][i] + bG[i];
                        res[i] = ua * ug * __builtin_amdgcn_rcpf(1.f + __expf(-ug));
                    }
                    const int rowl = ai * HALF + wr * 64 + m * 16 + fr;
                    const bool ok = !((rowl == 0 && !first) || (rowl == 255 && !last));
                    if (ok) { u32x2 w; w.x = cvt_pk_bf16(res[0], res[1]); w.y = cvt_pk_bf16(res[2], res[3]);
                        gst<u32x2>(ACT + (size_t)(pm * BM + rowl) * DFF + pn * 128 + lc0 + 4 * n, w); }
                }
            }
        }
    }
};
}

__device__ __forceinline__ f32x4 ld_bf4(const bf16_t* p) { const u32x2 w = gld<u32x2>(p); return (f32x4){__uint_as_float(w.x << 16), __uint_as_float(w.x & 0xffff0000u), __uint_as_float(w.y << 16), __uint_as_float(w.y & 0xffff0000u)}; }
struct FaArgs {
    const bf16_t* q; int q_pitch;
    const bf16_t* kn; int kn_pitch;
    const bf16_t* kr; int kr_pitch;
    const bf16_t* vt; int vt_pitch;
    int tok0, nt0, tok1, nt1;
    int j0, qpos0;
    float sink2; int has_sink;
    bf16_t* o; int o_pitch;
    const float* cosT; const float* sinT;
};
__device__ __forceinline__ int crow(int r, int hi) { return (r & 3) + 8 * (r >> 2) + 4 * hi; }
template <int DQK, bool WINDOW, bool ROPEQ>
__device__ __forceinline__ void fa_unit(LAS unsigned char* lds, const FaArgs a) {
    constexpr int KROW = (DQK + 8) * 2, VROW = 136, BUFB = 64 * 208 + 64 * VROW, SCR = 5 * BUFB, ND = DQK / 16;
    constexpr float THR = 5.f;
    int tid_ = threadIdx.x; asm volatile("" : "+v"(tid_));
    const int tid = tid_, lane = tid & 63, r32 = lane & 31, hi = lane >> 5; const int wid = __builtin_amdgcn_readfirstlane(tid >> 6);
    LAS float* wsf = (LAS float*)(lds + SCR) + wid * 64;
    __syncthreads();
    bf16x8 qr[ND];
    const bf16_t* qrow = a.q + (size_t)(wid * 32 + r32) * a.q_pitch;
#pragma unroll
    for (int d0 = 0; d0 < ND; ++d0) qr[d0] = gld<bf16x8>(qrow + d0 * 16 + hi * 8);
    if (ROPEQ) {
        const int pos = a.qpos0 + wid * 32 + r32;
#pragma unroll
        for (int d0 = 4; d0 < ND; ++d0) {
            const int bidx = 2 * (d0 - 4) + hi;
            const bf16x8 own = qr[d0], oth = gld<bf16x8>(qrow + 64 + 8 * (bidx ^ 1));
            const int pc = (bidx < 2) ? (pos >> 6) : (pos & 63);
            const f32x4 c0 = gld<f32x4>(a.cosT + pc * 8), c1 = gld<f32x4>(a.cosT + pc * 8 + 4), s0 = gld<f32x4>(a.sinT + pc * 8), s1 = gld<f32x4>(a.sinT + pc * 8 + 4);
            float o8[8];
#pragma unroll
            for (int e = 0; e < 8; ++e) { const float xo = bf2f((bf16_t)own[e]), xp = bf2f((bf16_t)oth[e]); const float c = e < 4 ? c0[e & 3] : c1[e & 3], s = e < 4 ? s0[e & 3] : s1[e & 3];
                o8[e] = (bidx & 1) ? (xo * c + xp * s) : (xo * c - xp * s); }
            u32x4 w; w.x = cvt_pk_bf16(o8[0], o8[1]); w.y = cvt_pk_bf16(o8[2], o8[3]); w.z = cvt_pk_bf16(o8[4], o8[5]); w.w = cvt_pk_bf16(o8[6], o8[7]);
            qr[d0] = __builtin_bit_cast(bf16x8, w);
        }
    }
    const int NT = a.nt0 + a.nt1;
    u32x4 rkA, rrA = {0, 0, 0, 0}, rvA, rkB, rrB = {0, 0, 0, 0}, rvB;
#define FA_TOK(t) ((t) < a.nt0 ? a.tok0 + 64 * (t) : a.tok1 + 64 * ((t) - a.nt0))
#define FA_ISSUE(t, S) do { const int tc_ = (t) < NT ? (t) : NT - 1; const int tb_ = FA_TOK(tc_); rk##S = gld<u32x4>(a.kn + (size_t)(tb_ + (tid >> 3)) * a.kn_pitch + (tid & 7) * 8); \
        if (DQK == 96) { if (tid < 256) rr##S = gld<u32x4>(a.kr + (size_t)(tb_ + (tid >> 2)) * a.kr_pitch + (tid & 3) * 8); } \
        rv##S = gld<u32x4>(a.vt + (size_t)(tid >> 3) * a.vt_pitch + tb_ + (tid & 7) * 8); } while (0)
#define FA_WRITE(buf, S) do { LAS unsigned char* kb_ = lds + (buf) * BUFB; *(LAS u32x4*)(kb_ + (tid >> 3) * KROW + (tid & 7) * 16) = rk##S; \
        if (DQK == 96) { if (tid < 256) *(LAS u32x4*)(kb_ + (tid >> 2) * KROW + 128 + (tid & 3) * 16) = rr##S; } \
        { LAS unsigned char* vd_ = kb_ + 64 * 208 + (tid >> 3) * VROW + (tid & 7) * 16; *(LAS u32x2*)vd_ = (u32x2){rv##S.x, rv##S.y}; *(LAS u32x2*)(vd_ + 8) = (u32x2){rv##S.z, rv##S.w}; } } while (0)
#define FA_KLOADH(buf, h) do { const LAS unsigned char* Kb_ = lds + (buf) * BUFB; \
        _Pragma("unroll") for (int d1 = 0; d1 < ND / 2; ++d1) { const int d0 = (h) * (ND / 2) + d1; \
            kf[2 * d1] = *(const LAS bf16x8*)(Kb_ + r32 * KROW + d0 * 32 + hi * 16); \
            kf[2 * d1 + 1] = *(const LAS bf16x8*)(Kb_ + (32 + r32) * KROW + d0 * 32 + hi * 16); } } while (0)
#define FA_QKMH(P0, P1, h) do { \
        _Pragma("unroll") for (int d1 = 0; d1 < ND / 2; ++d1) { const int d0 = (h) * (ND / 2) + d1; \
            if ((h) == 0 && d1 == 0) { P0 = __builtin_amdgcn_mfma_f32_32x32x16_bf16(kf[0], qr[0], negm, 0, 0, 0); P1 = __builtin_amdgcn_mfma_f32_32x32x16_bf16(kf[1], qr[0], negm, 0, 0, 0); } \
            else { P0 = __builtin_amdgcn_mfma_f32_32x32x16_bf16(kf[2 * d1], qr[d0], P0, 0, 0, 0); P1 = __builtin_amdgcn_mfma_f32_32x32x16_bf16(kf[2 * d1 + 1], qr[d0], P1, 0, 0, 0); } } } while (0)
    bf16x8 kf[ND];
    float mhat = 0.f, lsum = 0.f;
    f32x16 negm = {};
    f32x16 o0 = {}, o1 = {};
    f32x16 sc0, sc1, sn0, sn1;
    int s0 = 0;
#define FA_W5(x) ((x) >= 5 ? (x) - 5 : (x))
#define FA_MX(a_, b_) __builtin_amdgcn_fmed3f((a_), (b_), __builtin_inff())
    FA_ISSUE(0, A); FA_ISSUE(1, B); FA_WRITE(0, A); FA_ISSUE(2, A); FA_WRITE(1, B); FA_ISSUE(3, B); FA_WRITE(2, A); __syncthreads();
    FA_KLOADH(0, 0); FA_QKMH(sc0, sc1, 0); FA_KLOADH(0, 1); FA_QKMH(sc0, sc1, 1);
#define FA_STEP(t, RW, RL, BAR) do { \
        FA_KLOADH(FA_W5(s0 + 1), 0); \
        if (WINDOW) { if ((t) < a.nt0) { \
            const int qp = a.qpos0 + wid * 32 + r32, jb = a.j0 + 64 * (t); \
            _Pragma("unroll") for (int r = 0; r < 16; ++r) { const int d0_ = qp - (jb + crow(r, hi)), d1_ = d0_ - 32; \
                if (d0_ > 128 || d0_ < -128) sc0[r] = -1e30f; if (d1_ > 128 || d1_ < -128) sc1[r] = -1e30f; } } } \
        float rm = FA_MX(sc0[0], sc1[0]); \
        if (WINDOW) { _Pragma("unroll") for (int r = 1; r < 16; ++r) rm = FA_MX(rm, FA_MX(sc0[r], sc1[r])); } \
        else { rm = FA_MX(FA_MX(rm, sc0[5]), FA_MX(sc0[10], sc0[15])); rm = FA_MX(FA_MX(rm, sc1[2]), FA_MX(sc1[7], sc1[13])); }     \
        { auto rr_ = __builtin_amdgcn_permlane32_swap(__float_as_uint(rm), __float_as_uint(rm), false, false); rm = FA_MX(__uint_as_float(rr_[0]), __uint_as_float(rr_[1])); } \
        if ((t) == 0 || __any(rm > THR)) { \
            const float dl = (t) == 0 ? FA_MX(rm, -100.f) : FA_MX(rm, 0.f); const float f = __builtin_amdgcn_exp2f(-dl); \
            lsum *= f; mhat += dl; \
            _Pragma("unroll") for (int r = 0; r < 16; ++r) { sc0[r] -= dl; sc1[r] -= dl; negm[r] = -mhat; } \
            if (hi == 0) wsf[r32] = f; \
            LDS_WAIT(); \
            _Pragma("unroll") for (int r = 0; r < 16; ++r) { const float fr_ = wsf[crow(r, hi)]; o0[r] *= fr_; o1[r] *= fr_; } \
        } \
        __builtin_amdgcn_sched_barrier(0); \
        FA_ISSUE((t) + 4, RL); \
        FA_QKMH(sn0, sn1, 0); FA_KLOADH(FA_W5(s0 + 1), 1); \
        float ps = 0.f; \
        _Pragma("unroll") for (int r = 0; r < 16; ++r) { sc0[r] = __builtin_amdgcn_exp2f(sc0[r]); sc1[r] = __builtin_amdgcn_exp2f(sc1[r]); ps += sc0[r] + sc1[r]; } \
        lsum += ps; \
        FA_QKMH(sn0, sn1, 1); \
        u32x4 pw[4]; \
        _Pragma("unroll") for (int k = 0; k < 2; ++k) { \
            pw[k]     = (u32x4){cvt_pk_bf16(sc0[8 * k], sc0[8 * k + 1]), cvt_pk_bf16(sc0[8 * k + 2], sc0[8 * k + 3]), cvt_pk_bf16(sc0[8 * k + 4], sc0[8 * k + 5]), cvt_pk_bf16(sc0[8 * k + 6], sc0[8 * k + 7])}; \
            pw[2 + k] = (u32x4){cvt_pk_bf16(sc1[8 * k], sc1[8 * k + 1]), cvt_pk_bf16(sc1[8 * k + 2], sc1[8 * k + 3]), cvt_pk_bf16(sc1[8 * k + 4], sc1[8 * k + 5]), cvt_pk_bf16(sc1[8 * k + 6], sc1[8 * k + 7])}; } \
        { const LAS unsigned char* Vb = lds + s0 * BUFB + 64 * 208; \
        _Pragma("unroll") for (int ks = 0; ks < 4; ++ks) { \
            const bf16x8 pa = __builtin_bit_cast(bf16x8, pw[ks]); \
            _Pragma("unroll") for (int dh = 0; dh < 2; ++dh) { \
                const LAS unsigned char* vp = Vb + (dh * 32 + r32) * VROW + (16 * ks + 4 * hi) * 2; \
                const s16x4 vl = *(const LAS s16x4*)vp, vh = *(const LAS s16x4*)(vp + 16); \
                const bf16x8 vb = {vl[0], vl[1], vl[2], vl[3], vh[0], vh[1], vh[2], vh[3]}; \
                if (dh == 0) o0 = __builtin_amdgcn_mfma_f32_32x32x16_bf16(pa, vb, o0, 0, 0, 0); else o1 = __builtin_amdgcn_mfma_f32_32x32x16_bf16(pa, vb, o1, 0, 0, 0); } } } \
        __builtin_amdgcn_sched_group_barrier(0x020, 3, 0); __builtin_amdgcn_sched_group_barrier(0x100, 16, 0); \
        _Pragma("unroll") for (int i_ = 0; i_ < 2 * ND; ++i_) { __builtin_amdgcn_sched_group_barrier(0x008, 1, 0); __builtin_amdgcn_sched_group_barrier(0x002, (DQK == 96 ? 7 : 10), 0); } \
        _Pragma("unroll") for (int i_ = 0; i_ < 8; ++i_) { __builtin_amdgcn_sched_group_barrier(0x008, 1, 0); __builtin_amdgcn_sched_group_barrier(0x002, 4, 0); } \
        __builtin_amdgcn_sched_barrier(0); \
        FA_WRITE(FA_W5(s0 + 3), RW); \
        if (BAR) __syncthreads(); \
        sc0 = sn0; sc1 = sn1; s0 = FA_W5(s0 + 1); \
    } while (0)
    for (int t = 0; t < NT; t += 2) { FA_STEP(t, B, A, false); FA_STEP(t + 1, A, B, true); }
#undef FA_W5
#undef FA_MX
#undef FA_STEP
#undef FA_QKMH
#undef FA_KLOADH
    lsum += __shfl_xor(lsum, 32);
    if (a.has_sink) lsum += __builtin_amdgcn_exp2f(a.sink2 - mhat);
    const float inv = 1.f / lsum;
    if (hi == 0) wsf[r32] = inv;
    LDS_WAIT();
#pragma unroll
    for (int r = 0; r < 16; ++r) { const int qq = crow(r, hi); const float s = wsf[qq];
        bf16_t* op = a.o + (size_t)(wid * 32 + qq) * a.o_pitch + r32;
        gst<bf16_t>(op, f2bf(o0[r] * s)); gst<bf16_t>(op + 32, f2bf(o1[r] * s)); }
#undef FA_TOK
#undef FA_ISSUE
#undef FA_WRITE
}


#define XB_TMO      128
#define XB_XCNT(j)  (256  + 64 * (j))
#define XB_XSUB(j)  (1280 + 64 * (j))
#define XB_XGEN(j)  (2304 + 64 * (j))
#define XB_TOP      3328
#define XB_TOPGEN   3392
#define XCD_BAR_WORDS 3456
#define XB_SPIN_CAP (1u << 22)
__device__ __forceinline__ unsigned xb_ld(unsigned* p)              { return __hip_atomic_load(p, __ATOMIC_RELAXED, __HIP_MEMORY_SCOPE_AGENT); }
__device__ __forceinline__ unsigned xb_add(unsigned* p, unsigned v) { return __hip_atomic_fetch_add(p, v, __ATOMIC_RELAXED, __HIP_MEMORY_SCOPE_AGENT); }
__device__ __forceinline__ unsigned xb_xcc_id() { return (unsigned)__builtin_amdgcn_s_getreg((3 << 11) | 20) & 0xFu; }
#define XB_SPIN(cond, bar) do { unsigned _sp = 0; while (cond) { __builtin_amdgcn_s_sleep(1); \
    if ((++_sp & 255u) == 0u) { if (xb_ld(&(bar)[XB_TMO])) break; if (_sp > XB_SPIN_CAP) { atomicAdd(&(bar)[XB_TMO], 1u); break; } } } } while (0)
__device__ __forceinline__ void xcd_barrier_complete(unsigned* bar, unsigned x, unsigned& nloc, unsigned& nx) {
    const unsigned G = gridDim.x * gridDim.y * gridDim.z;
    unsigned sum, cnt, mine, sp = 0u;
    for (;;) {
        sum = 0u; cnt = 0u; mine = 0u;
#pragma unroll
        for (unsigned j = 0; j < 16; ++j) { const unsigned c = xb_ld(&bar[XB_XCNT(j)]); sum += c; cnt += (c > 0u) ? 1u : 0u; mine = (j == x) ? c : mine; }
        if (sum == G) break;
        __builtin_amdgcn_s_sleep(1);
        if ((++sp & 255u) == 0u) { if (xb_ld(&bar[XB_TMO])) break; if (sp > XB_SPIN_CAP) { atomicAdd(&bar[XB_TMO], 1u); break; } }
    }
    nloc = mine > 0u ? mine : 1u; nx = cnt > 0u ? cnt : 1u;
}
__device__ __forceinline__ void xcd_barrier(unsigned* bar, volatile LAS unsigned* st) {
    asm volatile("s_waitcnt vmcnt(0)" ::: "memory");
    __syncthreads();
    if (threadIdx.x == 0) {
        const unsigned x = xb_xcc_id();
        __builtin_amdgcn_s_waitcnt(0);
        unsigned nloc = st[0], nx = st[1];
        if (nloc == 0u) { xcd_barrier_complete(bar, x, nloc, nx); st[0] = nloc; st[1] = nx; }
        const unsigned old = xb_add(&bar[XB_XSUB(x)], 1u);
        const unsigned gen = old / nloc;
        if (old + 1u == (gen + 1u) * nloc) {
            __builtin_amdgcn_fence(__ATOMIC_RELEASE, "agent");
            asm volatile("s_waitcnt vmcnt(0)" ::: "memory");
            const unsigned og = xb_add(&bar[XB_TOP], 1u);
            const unsigned tg = og / nx;
            if (og + 1u == (tg + 1u) * nx) xb_add(&bar[XB_TOPGEN], 1u);
            else XB_SPIN(xb_ld(&bar[XB_TOPGEN]) == tg, bar);
            __builtin_amdgcn_fence(__ATOMIC_ACQUIRE, "agent");
            xb_add(&bar[XB_XGEN(x)], 1u);
            asm volatile("s_waitcnt vmcnt(0)" ::: "memory");
        } else {
            XB_SPIN(xb_ld(&bar[XB_XGEN(x)]) == gen, bar);
            __builtin_amdgcn_fence(__ATOMIC_ACQUIRE, "agent");
            asm volatile("s_waitcnt vmcnt(0)" ::: "memory");
        }
    }
    __syncthreads();
}

constexpr int ARG_OFF = LDS_BYTES - 512;
__device__ __forceinline__ unsigned long long lds_arg(LAS unsigned char* lds, int i) {
    int off = ARG_OFF + 8 * i; asm volatile("" : "+v"(off));
    const unsigned long long v = *(const LAS unsigned long long*)(lds + off);
    const unsigned lo = __builtin_amdgcn_readfirstlane((unsigned)v), hi = __builtin_amdgcn_readfirstlane((unsigned)(v >> 32));
    return ((unsigned long long)hi << 32) | lo;
}
#define INP(i) ((const float*)lds_arg(lds, (i)))
struct Args { const float* in[24]; float* out; unsigned char* ws; int use_cg, pad; };
enum { I_XP = 0, I_XS, I_CWK, I_CWV, I_CCKV, I_CKR, I_C, I_CCTX, I_WADA, I_BADA, I_GMIX, I_WIN, I_SINK, I_GCQ, I_WUQ, I_GCKV, I_WUKV, I_WOUT, I_GFFN, I_WUG, I_CONVW, I_CONVB, I_WDOWN, I_GFINAL };

__device__ __forceinline__ void transpose_item(const float* W, int srcN, int ksrc0, int kvalid, int scol0, bf16_t* dst, int dpitch, const float* kscale, float scale, LAS float* scr, int lane) {
    float tv[32];
#pragma unroll
    for (int i = 0; i < 32; ++i) { const int k = ksrc0 + 2 * i + (lane >> 5); tv[i] = 0.f;
        if (scol0 >= 0 && k < kvalid) tv[i] = W[(size_t)k * srcN + scol0 + (lane & 31)]; }
#pragma unroll
    for (int i = 0; i < 32; ++i) { const int kk = 2 * i + (lane >> 5), k = ksrc0 + kk; float v = tv[i] * scale;
        if (kscale) { if (scol0 >= 0 && k < kvalid) v *= kscale[k]; }
        scr[kk * 33 + (lane & 31)] = v; }
    LDS_WAIT(); asm volatile("" ::: "memory");
    const int c = lane & 7;
#pragma unroll
    for (int j = 0; j < 4; ++j) { const int n = (lane >> 3) + 8 * j; const LAS float* s = scr + (8 * c) * 33 + n;
        u32x4 o; o.x = cvt_pk_bf16(s[0 * 33], s[1 * 33]); o.y = cvt_pk_bf16(s[2 * 33], s[3 * 33]); o.z = cvt_pk_bf16(s[4 * 33], s[5 * 33]); o.w = cvt_pk_bf16(s[6 * 33], s[7 * 33]);
        *(u32x4*)(dst + (size_t)n * dpitch + 8 * c) = o; }
    LDS_WAIT(); asm volatile("" ::: "memory");
}

__global__ void __launch_bounds__(512, 2) mk_fwd(Args args) {
    extern __shared__ __attribute__((aligned(16))) unsigned char lds_raw[];
    LAS unsigned char* lds = (LAS unsigned char*)lds_raw;
    cg::grid_group grid = cg::this_grid();
    const int tid0 = threadIdx.x;
    if (tid0 < 24) ((LAS unsigned long long*)(lds + ARG_OFF))[tid0] = (unsigned long long)args.in[tid0];
    if (tid0 == 24) ((LAS unsigned long long*)(lds + ARG_OFF))[24] = (unsigned long long)args.out;
    if (tid0 == 25) ((LAS unsigned long long*)(lds + ARG_OFF))[25] = (unsigned long long)args.ws;
    if (tid0 == 26) { ((LAS unsigned*)(lds + ARG_OFF + 256))[0] = 0u; ((LAS unsigned*)(lds + ARG_OFF + 256))[1] = 0u; }
    if (tid0 == 0) (void)xb_add((unsigned*)args.ws + XB_XCNT(xb_xcc_id()), 1u);
    __syncthreads();
#define WS_PTRS \
    int tidl_ = threadIdx.x; asm volatile("" : "+v"(tidl_)); const int tid = tidl_, lane = tid & 63, wave = __builtin_amdgcn_readfirstlane(tid >> 6); \
    int bxl_ = blockIdx.x; asm volatile("" : "+s"(bxl_)); const int G = gridDim.x, bx = bxl_; const int vcu = (G % 8 == 0) ? (bx % 8) * (G / 8) + bx / 8 : bx; \
    const int gw = vcu * 8 + wave, NGW = G * 8, gt = bx * 512 + tid, GT = G * 512; (void)gw; (void)NGW; (void)gt; (void)GT; (void)lane; \
    unsigned char* ws = (unsigned char*)lds_arg(lds, 25); float* out = (float*)lds_arg(lds, 24); \
    float* MOD = (float*)(ws + WS_MOD); \
    float* cosA = (float*)(ws + WS_TAB + T_COSA); float* sinA = (float*)(ws + WS_TAB + T_SINA); float* cosC = (float*)(ws + WS_TAB + T_COSC); float* sinC = (float*)(ws + WS_TAB + T_SINC); \
    bf16_t* TABC = (bf16_t*)(ws + WS_TAB + T_TABC); bf16_t* TABS = (bf16_t*)(ws + WS_TAB + T_TABS); bf16_t* DFT256 = (bf16_t*)(ws + WS_DFT256); \
    bf16_t* H = (bf16_t*)(ws + WS_H); bf16_t* MIX = (bf16_t*)(ws + WS_H); \
    bf16_t* PROJ = (bf16_t*)(ws + WS_PROJ); bf16_t* DFT = (bf16_t*)(ws + WS_DFT); \
    bf16_t* QA = (bf16_t*)(ws + WS_QA); bf16_t* KA = (bf16_t*)(ws + WS_KA); bf16_t* CQN = (bf16_t*)(ws + WS_CQN); bf16_t* CKVN = (bf16_t*)(ws + WS_CKVN); \
    bf16_t* QC = (bf16_t*)(ws + WS_QC); bf16_t* KC = (bf16_t*)(ws + WS_KC); bf16_t* VT = (bf16_t*)(ws + WS_VT); bf16_t* KR = (bf16_t*)(ws + WS_KR); bf16_t* XT = (bf16_t*)(ws + WS_XT); \
    bf16_t* ACT = (bf16_t*)(ws + WS_ACT); float* EDGE = (float*)(ws + WS_EDGE);
#ifndef REP_P5
#define REP_P5 1
#endif
#ifndef REP_P3
#define REP_P3 1
#endif
#ifndef REP_P4
#define REP_P4 1
#endif
#ifndef REP_P8
#define REP_P8 1
#endif
#ifndef REP_P0
#define REP_P0 1
#endif
#ifndef REP_P2
#define REP_P2 1
#endif
#ifndef REP_P1
#define REP_P1 1
#endif
#define PH_BEGIN { WS_PTRS
#define PH_BEGIN_L PH_BEGIN unsigned char* wl = ws + WS_W + (size_t)l * W_LSTRIDE; const float* modl = MOD + (size_t)l * 5 * 6144; (void)wl; (void)modl;
#define PH_END   xcd_barrier((unsigned*)ws, (volatile LAS unsigned*)(lds + ARG_OFF + 256)); }
#define PH_END_CG xcd_barrier((unsigned*)ws, (volatile LAS unsigned*)(lds + ARG_OFF + 256)); if (args.use_cg) grid.sync(); }

    for (int rep_ = 0; rep_ < REP_P0; ++rep_)
    PH_BEGIN
    {
        LAS float* red = (LAS float*)lds;
        LAS float* sil = (LAS float*)(lds + 16384);
        if (bx < 192) {
            for (int i = tid; i < 5 * 1024; i += 512) { const int j = i >> 10, k = i & 1023; const float cv = j == 0 ? INP(I_CCTX)[k] : INP(I_C)[(j - 1) * DM + k]; sil[i] = cv / (1.f + __expf(-cv)); }
            __syncthreads();
        }
        for (int it = bx; it < 192; it += G) {
            const int l = it / 96, cgp = it % 96, col = cgp * 64 + lane;
            const float* wa = INP(I_WADA) + (size_t)l * DM * 6144 + col;
            float ac[5] = {0.f, 0.f, 0.f, 0.f, 0.f};
#pragma unroll 16
            for (int kk = 0; kk < 128; ++kk) { const int k = wave * 128 + kk; const float wv = wa[(size_t)k * 6144];
#pragma unroll
                for (int j = 0; j < 5; ++j) ac[j] += sil[j * 1024 + k] * wv; }
#pragma unroll
            for (int j = 0; j < 5; ++j) red[(wave * 5 + j) * 64 + lane] = ac[j];
            __syncthreads();
            if (tid < 320) { const int j = tid >> 6; float s = 0.f;
#pragma unroll
                for (int w = 0; w < 8; ++w) s += red[(w * 5 + j) * 64 + lane];
                MOD[(size_t)(l * 5 + j) * 6144 + col] = s + INP(I_BADA)[l * 6144 + col]; }
            __syncthreads();
        }
    }
    {
        LAS float* t64 = (LAS float*)(lds + 120000);
        if (tid < 64) { t64[tid] = cospif((float)tid * (1.f / 32.f)); t64[64 + tid] = -sinpif((float)tid * (1.f / 32.f)); }
        __syncthreads();
        LAS float* scr = (LAS float*)(lds) + wave * (64 * 33);
        constexpr int J0 = 768, J1 = 256, J2 = 128, J3 = 2816, J4 = 1408, J5 = 64, J6 = 16, J7 = 16, J8 = 1024, JL = J0 + J1 + J2 + J3 + J4 + J5 + J6 + J7;
        const int wrk_ = bx * 8 + wave, nex_ = (bx >= 192 && G == 256) ? 4 : 0, nbase_ = (G == 256) ? 2048 : 0;
        for (int k_ = 0;; ++k_) {
            const int it = k_ < nex_ ? (wrk_ - 1536) + k_ * 512 : nbase_ + wrk_ + (k_ - nex_) * NGW;
            if (it >= 2 * J8 + 2 * JL) break;
            if (it < 2 * J8) {
                const int l = it / J8, r = it % J8, cb = r & 7, g = (r >> 3) / 32, nb = (r >> 3) % 32; const float* W = INP(I_WOUT) + (size_t)l * DM * DM;
                unsigned char* wl = ws + WS_W + (size_t)l * W_LSTRIDE;
                float tv[32];
#pragma unroll
                for (int i = 0; i < 32; ++i) tv[i] = W[(size_t)(512 + g * 64 + 2 * i + (lane >> 5)) * 1024 + nb * 32 + (lane & 31)];
#pragma unroll
                for (int i = 0; i < 32; ++i) scr[(2 * i + (lane >> 5)) * 33 + (lane & 31)] = tv[i];
                LDS_WAIT(); asm volatile("" ::: "memory");
                const int n = lane & 31, cs = lane >> 5;
                bf16_t* dst = (bf16_t*)(wl + WO_OUT) + (size_t)(nb * 32 + n) * MIXW + 512 + g * 128 + cs * 64;
                float a8[8] = {0.f, 0.f, 0.f, 0.f, 0.f, 0.f, 0.f, 0.f};
                for (int cp = 0; cp < 64; ++cp) { const float w = scr[cp * 33 + n];
#pragma unroll
                    for (int e = 0; e < 8; ++e) { const int id = ((cb * 8 + e) * cp) & 63; a8[e] += t64[cs * 64 + id] * w; } }
                u32x4 o; o.x = cvt_pk_bf16(a8[0], a8[1]); o.y = cvt_pk_bf16(a8[2], a8[3]); o.z = cvt_pk_bf16(a8[4], a8[5]); o.w = cvt_pk_bf16(a8[6], a8[7]);
                *(u32x4*)(dst + cb * 8) = o;
                LDS_WAIT(); asm volatile("" ::: "memory");
                continue;
            }
            const int itw = it - 2 * J8;
            const int l = itw / JL; int r = itw % JL;
            unsigned char* wl = ws + WS_W + (size_t)l * W_LSTRIDE;
            if (r < J0) { const int kb = r / 48, nb = r % 48; const float* W = INP(I_WIN) + (size_t)l * DM * 1376;
                transpose_item(W, 1376, kb * 64, 1024, nb < 43 ? nb * 32 : -1, (bf16_t*)(wl + WO_IN) + (size_t)(nb * 32) * 1024 + kb * 64, 1024, nullptr, 1.f, scr, lane); continue; } r -= J0;
            if (r < J1) { const int kb = r / 32, nb = r % 32; const float* W = INP(I_WOUT) + (size_t)l * DM * DM;
                transpose_item(W, 1024, kb * 64, 1024, nb * 32, (bf16_t*)(wl + WO_OUT) + (size_t)(nb * 32) * MIXW + kb * 64, MIXW, nullptr, 1.f, scr, lane); continue; } r -= J1;
            if (r < J2) { const int kb = r / 32, nb = r % 32; const float* W = INP(I_WOUT) + (size_t)l * DM * DM;
                transpose_item(W, 1024, 768 + kb * 64, 1024, nb * 32, (bf16_t*)(wl + WO_OUT) + (size_t)(nb * 32) * MIXW + 1024 + kb * 64, MIXW, nullptr, 1.f, scr, lane); continue; } r -= J2;
            if (r < J3) { const int kb = r / 176, nb = r % 176; const float* W = INP(I_WUG) + (size_t)l * DM * 5632;
                const int n0 = nb * 32, pn = n0 >> 8, rr = n0 & 255; const int sc = rr < 128 ? 128 * pn + rr : DFF + 128 * pn + (rr - 128);
                transpose_item(W, 5632, kb * 64, 1024, sc, (bf16_t*)(wl + WO_UG) + (size_t)n0 * 1024 + kb * 64, 1024, nullptr, 1.f, scr, lane); continue; } r -= J3;
            if (r < J4) { const int kb = r / 32, nb = r % 32; const float* W = INP(I_WDOWN) + (size_t)l * DFF * DM;
                transpose_item(W, 1024, kb * 64, DFF, nb * 32, (bf16_t*)(wl + WO_DN) + (size_t)(nb * 32) * DFF + kb * 64, DFF, nullptr, 1.f, scr, lane); continue; } r -= J4;
            if (r < J5) { const int kb = r / 16, nb = r % 16; const float* W = INP(I_WUQ) + (size_t)l * 192 * 384;
                transpose_item(W, 384, kb * 64, 192, nb < 12 ? nb * 32 : -1, (bf16_t*)(wl + WO_UQ) + (size_t)(nb * 32) * 256 + kb * 64, 256, INP(I_GCQ) + l * 192, QS_C, scr, lane); continue; } r -= J5;
            if (r < J6) { const int kb = r / 8, nb = r % 8; const float* W = INP(I_WUKV) + (size_t)l * 128 * 512; const int n0 = nb * 32;
                transpose_item(W, 512, kb * 64, 128, (n0 >> 6) * 128 + (n0 & 63), (bf16_t*)(wl + WO_WK) + (size_t)n0 * 128 + kb * 64, 128, nullptr, 1.f, scr, lane); continue; } r -= J6;
            if (r < J7) { const int kb = r / 8, nb = r % 8; const float* W = INP(I_WUKV) + (size_t)l * 128 * 512; const int n0 = nb * 32;
                transpose_item(W, 512, kb * 64, 128, (n0 >> 6) * 128 + 64 + (n0 & 63), (bf16_t*)(wl + WO_WV) + (size_t)n0 * 128 + kb * 64, 128, nullptr, 1.f, scr, lane); continue; } r -= J7;
        }
    }
    {
        for (int i = gt; i < 1024; i += GT) { const int p = i >> 4, k = i & 15; const float ang = (float)p * powf(10000.f, -(float)k / 16.f); cosA[i] = cosf(ang); sinA[i] = sinf(ang); }
        for (int i = gt; i < 512; i += GT) { const int p = i >> 3, k = i & 7; const float ang = (float)p * powf(10000.f, -(float)k / 8.f); cosC[i] = cosf(ang); sinC[i] = sinf(ang); }
        for (int i = gt; i < 4096; i += GT) { TABC[i] = f2bf(cospif((float)i * (1.f / 2048.f))); TABS[i] = f2bf(sinpif((float)i * (1.f / 2048.f))); }
        for (int i = gt; i < 512 * 256; i += GT) { const int row = i >> 8, n = i & 255, cs = row >> 8, kp = row & 255; const int id = (kp * n) & 255;
            DFT256[i] = f2bf(cs ? sinpif((float)id * (1.f / 128.f)) : cospif((float)id * (1.f / 128.f))); }
    }
    PH_END_CG

    for (int l = 0; l < 2; ++l) {
        for (int rep_ = 0; rep_ < REP_P1; ++rep_)
        PH_BEGIN_L
#define P1_XR(r) ((l == 0) ? ((r) < NCTX ? xp_ + (size_t)(r) * DM : xs_ + (size_t)((r) - NCTX) * DM) : out + (size_t)(r) * DM)
        const float* xp_ = INP(I_XP); const float* xs_ = INP(I_XS);
        f32x4 nv[4], nw[4];
#pragma unroll
        for (int j = 0; j < 4; ++j) { nv[j] = gld<f32x4>(P1_XR(gw) + 4 * lane + 256 * j); nw[j] = gld<f32x4>(P1_XR(gw + NGW) + 4 * lane + 256 * j); }
        for (int row = gw; row < NTOK; row += NGW) {
            const int mi = row < NCTX ? 0 : 1 + ((row - NCTX) >> 12);
            const float* sh = modl + mi * 6144, *sc = sh + 1024; const float* gm = INP(I_GMIX) + l * DM;
            f32x4 v[4]; float s = 0.f;
#pragma unroll
            for (int j = 0; j < 4; ++j) { v[j] = nv[j]; nv[j] = nw[j]; }
            { const int nr = row + 2 * NGW < NTOK ? row + 2 * NGW : row;
#pragma unroll
                for (int j = 0; j < 4; ++j) nw[j] = gld<f32x4>(P1_XR(nr) + 4 * lane + 256 * j); }
#pragma unroll
            for (int j = 0; j < 4; ++j) {
                if (l == 1 && row >= 16384) { const size_t po = (size_t)(row - 16384) * DM + 4 * lane + 256 * j; const bf16_t* pa = (const bf16_t*)(ws + 207 * MiB); const bf16_t* pb = (const bf16_t*)(ws + WS_W);
                    const f32x4 ps = (ld_bf4(pa + po) + ld_bf4(pa + 4194304 + po)) + (ld_bf4(pa + 2 * 4194304 + po) + ld_bf4(pb + po));
                    v[j] += *(const f32x4*)(MOD + 4 * 6144 + 5120 + 4 * lane + 256 * j) * ps; *(f32x4*)(out + (size_t)row * DM + 4 * lane + 256 * j) = v[j]; }
                s += v[j][0] * v[j][0] + v[j][1] * v[j][1] + v[j][2] * v[j][2] + v[j][3] * v[j][3]; }
            const float rstd = rsqrtf(wave_sum(s) * (1.f / DM) + EPSN);
            if (l == 0 && row >= 16384) {
#pragma unroll
                for (int j = 0; j < 4; ++j) *(f32x4*)(out + (size_t)row * DM + 4 * lane + 256 * j) = v[j]; }
#pragma unroll
            for (int j = 0; j < 4; ++j) { const int c = 4 * lane + 256 * j; const f32x4 g4 = *(const f32x4*)(gm + c), s4 = *(const f32x4*)(sc + c), h4 = *(const f32x4*)(sh + c);
                const f32x4 y = v[j] * rstd * g4 * (s4 + 1.f) + h4;
                u32x2 w; w.x = cvt_pk_bf16(y[0], y[1]); w.y = cvt_pk_bf16(y[2], y[3]); *(u32x2*)(H + (size_t)row * DM + c) = w; }
        }
        PH_END
        for (int rep_ = 0; rep_ < REP_P2; ++rep_)
        PH_BEGIN_L
        { pg8::Gemm g{H, (const bf16_t*)(wl + WO_IN), 1024, 1024, 1024, 256u * 1024 * 2, 256u * 1024 * 2}; pg8::StaticOrder S; S.init(80, 6, G, bx, 16);
          pg8::EpiStore E{PROJ, NPROJ, NPROJ, 1.f}; pg8::gemm_phase(lds, g, S, E); }
        PH_END
        for (int rep_ = 0; rep_ < REP_P3; ++rep_)
        PH_BEGIN_L
        { LAS float* tl = (LAS float*)lds;
          for (int i = tid; i < 1024; i += 512) { tl[i] = cosA[i]; tl[1024 + i] = sinA[i]; }
          tl[2048 + tid] = cosC[tid]; tl[2560 + tid] = sinC[tid];
          __syncthreads(); }
        u32x4 nrw[3], nrx[3];
#pragma unroll
        for (int j = 0; j < 3; ++j) { const int ch = lane + 64 * j < 172 ? lane + 64 * j : 171; nrw[j] = gld<u32x4>(PROJ + (size_t)gw * NPROJ + ch * 8); nrx[j] = gld<u32x4>(PROJ + (size_t)(gw + NGW) * NPROJ + ch * 8); }
        for (int row = gw; row < NTOK + 1024; row += NGW) {
            if (row >= NTOK) {
                const int j = row - NTOK, b = j >> 8, jj = j & 255; const size_t src = ((size_t)(b * 2 + l) * 256 + jj);
#pragma unroll
                for (int e = 0; e < 2; ++e) { const int c = lane + 64 * e;
                    KA[(size_t)row * 128 + c] = f2bf(INP(I_CWK)[src * 128 + c]);
                    XT[(size_t)c * TOKP + row] = f2bf(INP(I_CWV)[src * 128 + c]);
                    CKVN[(size_t)row * 128 + c] = f2bf(INP(I_CCKV)[src * 128 + c]); }
                if (lane < 32) KR[(size_t)row * 32 + lane] = f2bf(INP(I_CKR)[src * 32 + lane]);
                continue;
            }
            const bf16_t* pr = PROJ + (size_t)row * NPROJ;
            LAS unsigned char* wrow = lds + 12288 + wave * 2816;
#pragma unroll
            for (int j = 0; j < 3; ++j) { const int ch = lane + 64 * j; if (ch < 172) *(LAS u32x4*)(wrow + ch * 16) = nrw[j]; nrw[j] = nrx[j]; }
            { const bf16_t* npr = row + 2 * NGW < NTOK ? pr + (size_t)2 * NGW * NPROJ : pr;
#pragma unroll
                for (int j = 0; j < 3; ++j) { const int ch = lane + 64 * j < 172 ? lane + 64 * j : 171; nrx[j] = gld<u32x4>(npr + ch * 8); } }
            LDS_WAIT(); asm volatile("" ::: "memory");
            const bool ctx = row < NCTX; const int pos = ctx ? 0 : (row - NCTX) & 4095; const int prr = pos >> 6, pcc = pos & 63;
            const size_t srow = ctx ? ((size_t)((row >> 8) * 2 + l) * 256 + (row & 255)) : 0;
            const LAS float* tcA = (const LAS float*)lds; const LAS float* tsA = tcA + 1024; const LAS float* tcC = tcA + 2048; const LAS float* tsC = tcA + 2560;
            {
#pragma unroll
                for (int part = 0; part < 2; ++part) {
                    if (part == 1 && lane >= 16) break;
                    const int hh = lane >> 3, cc = lane & 7, base = (part ? 512 : 0) + hh * 64;
                    const bf16x8 own = *(const LAS bf16x8*)(wrow + (base + 8 * cc) * 2), oth = *(const LAS bf16x8*)(wrow + (base + 8 * (cc ^ 2)) * 2);
                    const int pc = (cc & 4) ? pcc : prr; const LAS float* cp = tcA + pc * 16 + 8 * (cc & 1); const LAS float* sp = tsA + pc * 16 + 8 * (cc & 1);
                    float y[8];
#pragma unroll
                    for (int e = 0; e < 8; ++e) { const float xo = bf2f((bf16_t)own[e]), xp = bf2f((bf16_t)oth[e]);
                        y[e] = ctx ? xo : ((cc & 2) ? xo * cp[e] + xp * sp[e] : xo * cp[e] - xp * sp[e]); }
                    if (part == 0) { const float q = QS_A; u32x4 w; w.x = cvt_pk_bf16(y[0] * q, y[1] * q); w.y = cvt_pk_bf16(y[2] * q, y[3] * q); w.z = cvt_pk_bf16(y[4] * q, y[5] * q); w.w = cvt_pk_bf16(y[6] * q, y[7] * q);
                        gst<u32x4>(QA + (size_t)row * 512 + hh * 64 + 8 * cc, w); }
                    else { u32x4 w; w.x = cvt_pk_bf16(y[0], y[1]); w.y = cvt_pk_bf16(y[2], y[3]); w.z = cvt_pk_bf16(y[4], y[5]); w.w = cvt_pk_bf16(y[6], y[7]);
                        gst<u32x4>(KA + (size_t)row * 128 + hh * 64 + 8 * cc, w);
                        if (ctx) { float* o = out + OUT_K + srow * 128 + hh * 64 + 8 * cc; gst<f32x4>(o, (f32x4){y[0], y[1], y[2], y[3]}); gst<f32x4>(o + 4, (f32x4){y[4], y[5], y[6], y[7]}); } }
                }
            }
            if (ctx && lane >= 16 && lane < 32) {
                const int c = (lane - 16) * 8; const bf16x8 v = *(const LAS bf16x8*)(wrow + (640 + c) * 2); float* o = out + OUT_V + srow * 128 + c;
                gst<f32x4>(o, (f32x4){bf2f((bf16_t)v[0]), bf2f((bf16_t)v[1]), bf2f((bf16_t)v[2]), bf2f((bf16_t)v[3])}); gst<f32x4>(o + 4, (f32x4){bf2f((bf16_t)v[4]), bf2f((bf16_t)v[5]), bf2f((bf16_t)v[6]), bf2f((bf16_t)v[7])}); }
            {
                const bool isq = lane < 24, isk = lane >= 32 && lane < 48; const int c = isq ? 1024 + lane * 8 : 1216 + (lane - 32) * 8;
                float v[8]; float ss = 0.f;
                if (isq || isk) { const bf16x8 x = *(const LAS bf16x8*)(wrow + c * 2);
#pragma unroll
                    for (int e = 0; e < 8; ++e) { v[e] = bf2f((bf16_t)x[e]); ss += v[e] * v[e]; } }
                else {
#pragma unroll
                    for (int e = 0; e < 8; ++e) v[e] = 0.f; }
                const float sq = wave_sum(isq ? ss : 0.f), sk = wave_sum(isk ? ss : 0.f);
                const float rq = rsqrtf(sq * (1.f / 192.f) + EPSN), rk = rsqrtf(sk * (1.f / 128.f) + EPSN);
                if (lane < 32) { u32x4 w; w.x = cvt_pk_bf16(v[0] * rq, v[1] * rq); w.y = cvt_pk_bf16(v[2] * rq, v[3] * rq); w.z = cvt_pk_bf16(v[4] * rq, v[5] * rq); w.w = cvt_pk_bf16(v[6] * rq, v[7] * rq);
                    gst<u32x4>(CQN + (size_t)row * 256 + lane * 8, w); }
                if (isk) { const int cc = (lane - 32) * 8; const float* gk = INP(I_GCKV) + l * 128 + cc; const f32x4 g0 = gld<f32x4>(gk), g1 = gld<f32x4>(gk + 4);
                    float y[8];
#pragma unroll
                    for (int e = 0; e < 8; ++e) y[e] = v[e] * rk * (e < 4 ? g0[e & 3] : g1[e & 3]);
                    u32x4 w; w.x = cvt_pk_bf16(y[0], y[1]); w.y = cvt_pk_bf16(y[2], y[3]); w.z = cvt_pk_bf16(y[4], y[5]); w.w = cvt_pk_bf16(y[6], y[7]);
                    gst<u32x4>(CKVN + (size_t)row * 128 + cc, w);
                    if (ctx) { float* o = out + OUT_CKV + srow * 128 + cc; gst<f32x4>(o, (f32x4){y[0], y[1], y[2], y[3]}); gst<f32x4>(o + 4, (f32x4){y[4], y[5], y[6], y[7]}); } }
            }
            if (lane >= 48 && lane < 52) {
                const int cc = lane - 48; const bf16x8 own = *(const LAS bf16x8*)(wrow + (1344 + 8 * cc) * 2), oth = *(const LAS bf16x8*)(wrow + (1344 + 8 * (cc ^ 1)) * 2);
                const int pc = (cc & 2) ? pcc : prr; const LAS float* cp = tcC + pc * 8; const LAS float* sp = tsC + pc * 8;
                float y[8];
#pragma unroll
                for (int e = 0; e < 8; ++e) { const float xo = bf2f((bf16_t)own[e]), xp = bf2f((bf16_t)oth[e]);
                    y[e] = ctx ? xo : ((cc & 1) ? xo * cp[e] + xp * sp[e] : xo * cp[e] - xp * sp[e]); }
                u32x4 w; w.x = cvt_pk_bf16(y[0], y[1]); w.y = cvt_pk_bf16(y[2], y[3]); w.z = cvt_pk_bf16(y[4], y[5]); w.w = cvt_pk_bf16(y[6], y[7]);
                gst<u32x4>(KR + (size_t)row * 32 + 8 * cc, w);
                if (ctx) { float* o = out + OUT_KR + srow * 32 + 8 * cc; gst<f32x4>(o, (f32x4){y[0], y[1], y[2], y[3]}); gst<f32x4>(o + 4, (f32x4){y[4], y[5], y[6], y[7]}); } }
            LDS_WAIT(); asm volatile("" ::: "memory");
        }
        {
            constexpr int TP = 784;
            for (int tile = bx; tile < NTOK / 64; tile += G) {
                __syncthreads();
                const int t0 = tile * 64;
#pragma unroll
                for (int e = 0; e < 6; ++e) { const int ch = tid + 512 * e, r = ch / 48, c16 = ch % 48;
                    *(LAS u32x4*)(lds + r * TP + c16 * 16) = *(const u32x4*)(PROJ + (size_t)(t0 + r) * NPROJ + 640 + c16 * 8); }
                __syncthreads();
#pragma unroll
                for (int e = 0; e < 6; ++e) { const int it = tid + 512 * e, col = it % 384, tc = it / 384;
                    unsigned short v8[8];
#pragma unroll
                    for (int k = 0; k < 8; ++k) v8[k] = *(const LAS unsigned short*)(lds + (tc * 8 + k) * TP + col * 2);
                    u32x4 w; w.x = v8[0] | ((unsigned)v8[1] << 16); w.y = v8[2] | ((unsigned)v8[3] << 16); w.z = v8[4] | ((unsigned)v8[5] << 16); w.w = v8[6] | ((unsigned)v8[7] << 16);
                    *(u32x4*)(XT + (size_t)col * TOKP + t0 + tc * 8) = w; }
            }
            __syncthreads();
        }
        PH_END
        for (int rep_ = 0; rep_ < REP_P4; ++rep_)
        PH_BEGIN_L
        {
            LAS bf16_t* tc = (LAS bf16_t*)lds; LAS bf16_t* ts = tc + 4096;
            for (int i = tid; i < 4096; i += 512) { tc[i] = TABC[i]; ts[i] = TABS[i]; }
            __syncthreads();
            for (int q = gt; q < 8192 * 256; q += GT) { const int rq = q >> 8, row = (rq & ~255) | ((rq + 17 * (rq >> 8)) & 255), n0 = (q & 255) * 8, cs = row >> 12, kp = row & 4095; const LAS bf16_t* tb = cs ? ts : tc;
                unsigned short v8[8];
#pragma unroll
                for (int k = 0; k < 8; ++k) v8[k] = tb[(kp * (n0 + k)) & 4095];
                u32x4 w; w.x = v8[0] | ((unsigned)v8[1] << 16); w.y = v8[2] | ((unsigned)v8[3] << 16); w.z = v8[4] | ((unsigned)v8[5] << 16); w.w = v8[6] | ((unsigned)v8[7] << 16);
                gst<u32x4>(DFT + (size_t)row * 2048 + n0, w); }
            {
                bf16_t* XE = (bf16_t*)(ws + WS_XE); bf16_t* XO = (bf16_t*)(ws + WS_XO); float* XH = (float*)(ws + WS_XH);
                for (int q = gt; q < 1024 * 256; q += GT) { const int r = q >> 8, n0 = (q & 255) * 8, b = r >> 8, ch = r & 255;
                    const bf16_t* xrow = XT + (size_t)(128 + ch) * TOKP + NCTX + 4096 * b;
                    const bf16x8 x0 = gld<bf16x8>(xrow + n0), xa = gld<bf16x8>(xrow + 4096 - n0 - 8);
                    const bf16_t xb0 = n0 ? gld<bf16_t>(xrow + 4096 - n0) : (bf16_t)0;
                    float e8[8], o8[8];
#pragma unroll
                    for (int e = 0; e < 8; ++e) { const float xv = bf2f((bf16_t)x0[e]); const float pv = e == 0 ? bf2f(xb0) : bf2f((bf16_t)xa[8 - e]); e8[e] = xv + pv; o8[e] = xv - pv; }
                    if (n0 == 0) { o8[0] = 0.f; XH[r] = bf2f(gld<bf16_t>(xrow + 2048)); }
                    u32x4 we, wo; we.x = cvt_pk_bf16(e8[0], e8[1]); we.y = cvt_pk_bf16(e8[2], e8[3]); we.z = cvt_pk_bf16(e8[4], e8[5]); we.w = cvt_pk_bf16(e8[6], e8[7]);
                    wo.x = cvt_pk_bf16(o8[0], o8[1]); wo.y = cvt_pk_bf16(o8[2], o8[3]); wo.z = cvt_pk_bf16(o8[4], o8[5]); wo.w = cvt_pk_bf16(o8[6], o8[7]);
                    gst<u32x4>(XE + (size_t)r * 2048 + n0, we); gst<u32x4>(XO + (size_t)r * 2048 + n0, wo); }
            }
            __syncthreads();
            { pg8::Gemm g{CQN, (const bf16_t*)(wl + WO_UQ), 256, 256, 256, 256u * 256 * 2, 256u * 256 * 2}; pg8::StaticOrder S; S.init(80, 2, G, bx, 4);
              pg8::EpiStore E{QC, 384, 384, 1.f}; pg8::gemm_phase(lds, g, S, E); }
            { pg8::Gemm g{CKVN, (const bf16_t*)(wl + WO_WK), 128, 128, 128, 256u * 128 * 2, 256u * 128 * 2}; pg8::StaticOrder S; S.init(84, 1, G, (bx + 96) & 255, 2);
              pg8::EpiStore E{KC, 256, 256, 1.f}; pg8::gemm_phase(lds, g, S, E); }
            { pg8::Gemm g{(const bf16_t*)(wl + WO_WV), CKVN, 128, 128, 128, 256u * 128 * 2, 256u * 128 * 2}; pg8::StaticOrder S; S.init(1, 84, G, (bx + 12) & 255, 2);
              pg8::EpiStore E{VT, TOKP, TOKP, 1.f}; pg8::gemm_phase(lds, g, S, E); }
        }
        PH_END
        for (int rep_ = 0; rep_ < REP_P5; ++rep_)
        PH_BEGIN_L
        {
            const float* sinkl = INP(I_SINK) + l * 8;
            {
                const int b = vcu >> 6, h = (vcu >> 4) & 3, qb = vcu & 15; const int r0 = NCTX + 4096 * b + 256 * qb;
                FaArgs a; a.q = QC + (size_t)r0 * 384 + h * 96; a.q_pitch = 384; a.kn = KC + h * 64; a.kn_pitch = 256; a.kr = KR; a.kr_pitch = 32; a.vt = VT + (size_t)(h * 64) * TOKP; a.vt_pitch = TOKP;
                a.tok0 = NCTX + 4096 * b; a.nt0 = 64; a.tok1 = NTOK + 256 * b; a.nt1 = 4; a.j0 = 0; a.qpos0 = 256 * qb; a.sink2 = 0.f; a.has_sink = 0;
                a.o = MIX + (size_t)r0 * MIXW + 1024 + h * 64; a.o_pitch = MIXW; a.cosT = cosC; a.sinT = sinC;
                fa_unit<96, false, true>(lds, a);
            }
            __syncthreads();
            {
                const int f = vcu >> 1; pg8::OneUnit S{(vcu & 1) == 0, f >> 2, f & 3, 32};
                pg8::Gemm g{DFT, (const bf16_t*)(ws + ((f >> 2) >= 16 ? WS_XO : WS_XE)), 2048, 2048, 2048, 256u * 2048 * 2, 256u * 2048 * 2};
                pg8::EpiF1 E{MIX, 0, 1.f / 512.f, (const float*)(ws + WS_XH)}; pg8::gemm_phase(lds, g, S, E);
            }
            {
                const int nA = (vcu & 1) ? 3 : 1;
                for (int k = 0; k < nA; ++k) {
                    const int idx = (vcu & 1) ? (vcu >> 1) * 3 + k : 384 + (vcu >> 1);
                    const int b = idx >> 7, hq = (idx >> 4) & 7, qb = idx & 15, kvh = hq >> 2; const int q0 = 256 * qb, r0 = NCTX + 4096 * b + q0;
                    const int jlo = q0 - 128 < 0 ? 0 : q0 - 128, jhi = q0 + 384 > 4096 ? 4096 : q0 + 384;
                    FaArgs a; a.q = QA + (size_t)r0 * 512 + hq * 64; a.q_pitch = 512; a.kn = KA + kvh * 64; a.kn_pitch = 128; a.kr = nullptr; a.kr_pitch = 0; a.vt = XT + (size_t)(kvh * 64) * TOKP; a.vt_pitch = TOKP;
                    a.tok0 = NCTX + 4096 * b + jlo; a.nt0 = (jhi - jlo) >> 6; a.tok1 = NTOK + 256 * b; a.nt1 = 4; a.j0 = jlo; a.qpos0 = q0; a.sink2 = sinkl[hq] * LOG2E; a.has_sink = 1;
                    a.o = MIX + (size_t)r0 * MIXW + hq * 64; a.o_pitch = MIXW; a.cosT = nullptr; a.sinT = nullptr;
                    fa_unit<64, true, false>(lds, a);
                }
            }
            {
                for (int k = 0; k < 1; ++k) {
                    const int j = vcu; if (j >= 224) break;
                    if (j < 128) { const int s = j >> 3, hq = j & 7, kvh = hq >> 2; const int r0 = 256 * s;
                        FaArgs a; a.q = QA + (size_t)r0 * 512 + hq * 64; a.q_pitch = 512; a.kn = KA + kvh * 64; a.kn_pitch = 128; a.kr = nullptr; a.kr_pitch = 0; a.vt = XT + (size_t)(kvh * 64) * TOKP; a.vt_pitch = TOKP;
                        a.tok0 = r0; a.nt0 = 4; a.tok1 = 0; a.nt1 = 0; a.j0 = 0; a.qpos0 = 0; a.sink2 = sinkl[hq] * LOG2E; a.has_sink = 1;
                        a.o = MIX + (size_t)r0 * MIXW + hq * 64; a.o_pitch = MIXW; a.cosT = nullptr; a.sinT = nullptr;
                        fa_unit<64, false, false>(lds, a);
                    } else if (j < 192) { const int jj = j - 128, s = jj >> 2, h = jj & 3; const int r0 = 256 * s;
                        FaArgs a; a.q = QC + (size_t)r0 * 384 + h * 96; a.q_pitch = 384; a.kn = KC + h * 64; a.kn_pitch = 256; a.kr = KR; a.kr_pitch = 32; a.vt = VT + (size_t)(h * 64) * TOKP; a.vt_pitch = TOKP;
                        a.tok0 = r0; a.nt0 = 4; a.tok1 = 0; a.nt1 = 0; a.j0 = 0; a.qpos0 = 0; a.sink2 = 0.f; a.has_sink = 0;
                        a.o = MIX + (size_t)r0 * MIXW + 1024 + h * 64; a.o_pitch = MIXW; a.cosT = nullptr; a.sinT = nullptr;
                        fa_unit<96, false, false>(lds, a);
                    } else { const int jj = j - 192; __syncthreads();
                        pg8::OneUnit S{1, jj & 1, jj >> 1, 4};
                        pg8::Gemm g{DFT256, XT + (size_t)128 * TOKP, 256, TOKP, 256, 256u * 256 * 2, (size_t)256 * 2};
                        pg8::EpiF1 E{MIX, 1, 1.f / 128.f, nullptr}; pg8::gemm_phase(lds, g, S, E);
                    }
                }
            }
        }
        PH_END
        PH_BEGIN_L
        { pg8::Gemm g{MIX, (const bf16_t*)(wl + WO_OUT), MIXW, MIXW, MIXW, 256u * MIXW * 2, 256u * MIXW * 2}; pg8::SplitOrder S{vcu, 20, 6};
          pg8::EpiResid E{l == 0 ? INP(I_XP) : out, l == 0 ? INP(I_XS) : out + (size_t)NCTX * DM, out, modl + 2048, (float*)(ws + WS_R), (float*)(ws + WS_R + 24 * MiB)}; pg8::gemm_phase<true>(lds, g, S, E); }
        PH_END
        PH_BEGIN_L
        f32x4 nv[4], nw[4];
#pragma unroll
        for (int j = 0; j < 4; ++j) { nv[j] = gld<f32x4>(out + (size_t)gw * DM + 4 * lane + 256 * j); nw[j] = gld<f32x4>(out + (size_t)(gw + NGW) * DM + 4 * lane + 256 * j); }
        for (int row = gw; row < NTOK; row += NGW) {
            const int mi = row < NCTX ? 0 : 1 + ((row - NCTX) >> 12);
            const float* sh = modl + mi * 6144 + 3072, *sc = sh + 1024; const float* gm = INP(I_GFFN) + l * DM;
            f32x4 v[4]; float s = 0.f;
#pragma unroll
            for (int j = 0; j < 4; ++j) { v[j] = nv[j]; nv[j] = nw[j]; }
            { const int nr = row + 2 * NGW < NTOK ? row + 2 * NGW : row;
#pragma unroll
                for (int j = 0; j < 4; ++j) nw[j] = gld<f32x4>(out + (size_t)nr * DM + 4 * lane + 256 * j); }
#pragma unroll
            for (int j = 0; j < 4; ++j) {
                if (row >= 16384) { const size_t po = (size_t)(row - 16384) * DM + 4 * lane + 256 * j; const bf16_t* pa = (const bf16_t*)(ws + WS_R);
                    const f32x4 ps = (ld_bf4(pa + po) + ld_bf4(pa + 4194304 + po)) + (ld_bf4(pa + 2 * 4194304 + po) + ld_bf4(pa + 3 * 4194304 + po));
                    v[j] += *(const f32x4*)(modl + 4 * 6144 + 2048 + 4 * lane + 256 * j) * ps; *(f32x4*)(out + (size_t)row * DM + 4 * lane + 256 * j) = v[j]; }
                s += v[j][0] * v[j][0] + v[j][1] * v[j][1] + v[j][2] * v[j][2] + v[j][3] * v[j][3]; }
            const float rstd = rsqrtf(wave_sum(s) * (1.f / DM) + EPSN);
#pragma unroll
            for (int j = 0; j < 4; ++j) { const int c = 4 * lane + 256 * j; const f32x4 g4 = *(const f32x4*)(gm + c), s4 = *(const f32x4*)(sc + c), h4 = *(const f32x4*)(sh + c);
                const f32x4 y = v[j] * rstd * g4 * (s4 + 1.f) + h4;
                u32x2 w; w.x = cvt_pk_bf16(y[0], y[1]); w.y = cvt_pk_bf16(y[2], y[3]); *(u32x2*)(H + (size_t)row * DM + c) = w; }
        }
        PH_END
        for (int rep_ = 0; rep_ < REP_P8; ++rep_)
        PH_BEGIN_L
        { pg8::Gemm g{H, (const bf16_t*)(wl + WO_UG), 1024, 1024, 1024, 256u * 1024 * 2, 256u * 1024 * 2}; pg8::StaticOrder S; S.init(80, 22, G, bx, 16);
          pg8::EpiConv E{ACT, EDGE, INP(I_CONVW) + (size_t)l * 3 * 5632, INP(I_CONVB) + (size_t)l * 5632}; pg8::gemm_phase(lds, g, S, E); }
        PH_END
        PH_BEGIN_L
        {
            const float* cw = INP(I_CONVW) + (size_t)l * 3 * 5632; const float* cb = INP(I_CONVB) + (size_t)l * 5632;
            for (int idx = gt; idx < 60 * DFF; idx += GT) { const int bnd = idx / DFF, j = idx % DFF; const int pm = 16 + (bnd / 15) * 16 + (bnd % 15);
                const float* e0 = EDGE + ((size_t)pm * 4 + 2) * 5632, *e1 = e0 + 5632, *e2 = EDGE + ((size_t)(pm + 1) * 4) * 5632, *e3 = e2 + 5632;
                const float wa0 = cw[j], wa1 = cw[5632 + j], wa2 = cw[2 * 5632 + j], ba = cb[j], wg0 = cw[DFF + j], wg1 = cw[5632 + DFF + j], wg2 = cw[2 * 5632 + DFF + j], bg = cb[DFF + j];
                { const float ua = e0[j] * wa0 + e1[j] * wa1 + e2[j] * wa2 + ba, ug = e0[DFF + j] * wg0 + e1[DFF + j] * wg1 + e2[DFF + j] * wg2 + bg;
                  ACT[(size_t)(pm * 256 + 255) * DFF + j] = f2bf(ua * ug / (1.f + __expf(-ug))); }
                { const float ua = e1[j] * wa0 + e2[j] * wa1 + e3[j] * wa2 + ba, ug = e1[DFF + j] * wg0 + e2[DFF + j] * wg1 + e3[DFF + j] * wg2 + bg;
                  ACT[(size_t)(pm * 256 + 256) * DFF + j] = f2bf(ua * ug / (1.f + __expf(-ug))); }
            }
        }
        PH_END
        PH_BEGIN_L
        { pg8::Gemm g{ACT, (const bf16_t*)(wl + WO_DN), DFF, DFF, DFF, 256u * DFF * 2, 256u * DFF * 2}; pg8::SplitOrder S{vcu, 44, 12};
          pg8::EpiResid E{out, out + (size_t)NCTX * DM, out, modl + 5120, (float*)(ws + 207 * MiB), (float*)wl}; pg8::gemm_phase<true>(lds, g, S, E); }
        PH_END
    }
    PH_BEGIN
    f32x4 nv[4], nw[4];
#pragma unroll
    for (int j = 0; j < 4; ++j) { nv[j] = gld<f32x4>(out + (size_t)gw * DM + 4 * lane + 256 * j); nw[j] = gld<f32x4>(out + (size_t)(gw + NGW) * DM + 4 * lane + 256 * j); }
    for (int row = gw; row < NTOK; row += NGW) {
        float* xr = out + (size_t)row * DM; const float* gm = INP(I_GFINAL);
        f32x4 v[4]; float s = 0.f;
#pragma unroll
        for (int j = 0; j < 4; ++j) { v[j] = nv[j]; nv[j] = nw[j]; }
        { const int nr = row + 2 * NGW < NTOK ? row + 2 * NGW : row;
#pragma unroll
            for (int j = 0; j < 4; ++j) nw[j] = gld<f32x4>(out + (size_t)nr * DM + 4 * lane + 256 * j); }
#pragma unroll
        for (int j = 0; j < 4; ++j) {
            if (row >= 16384) { const size_t po = (size_t)(row - 16384) * DM + 4 * lane + 256 * j; const bf16_t* pa = (const bf16_t*)(ws + 207 * MiB); const bf16_t* pb = (const bf16_t*)(ws + WS_W + W_LSTRIDE);
                const f32x4 ps = (ld_bf4(pa + po) + ld_bf4(pa + 4194304 + po)) + (ld_bf4(pa + 2 * 4194304 + po) + ld_bf4(pb + po));
                v[j] += *(const f32x4*)(MOD + 5 * 6144 + 4 * 6144 + 5120 + 4 * lane + 256 * j) * ps; }
            s += v[j][0] * v[j][0] + v[j][1] * v[j][1] + v[j][2] * v[j][2] + v[j][3] * v[j][3]; }
        const float rstd = rsqrtf(wave_sum(s) * (1.f / DM) + EPSN);
#pragma unroll
        for (int j = 0; j < 4; ++j) { const int c = 4 * lane + 256 * j; *(f32x4*)(xr + c) = v[j] * rstd * *(const f32x4*)(gm + c); }
    }
    }
#undef PH_BEGIN
#undef PH_END
}

extern "C" void kernel_launch(void* const* d_in, const int* in_sizes, int n_in, void* d_out, int out_size, void* d_ws, size_t ws_size, hipStream_t stream) {
    static int grid = 0;
    if (grid == 0) {
        int dev = 0, cus = 0, per_cu = 0;
        (void)hipGetDevice(&dev);
        (void)hipDeviceGetAttribute(&cus, hipDeviceAttributeMultiprocessorCount, dev);
        (void)hipFuncSetAttribute((const void*)mk_fwd, hipFuncAttributeMaxDynamicSharedMemorySize, LDS_BYTES);
        (void)hipOccupancyMaxActiveBlocksPerMultiprocessor(&per_cu, (const void*)mk_fwd, 512, LDS_BYTES);
        grid = (per_cu >= 1 && cus == 256) ? cus : -1;
        if (n_in != 24 || ws_size < 256 * MiB) { fprintf(stderr, "kernel_launch: unexpected n_in %d / ws %zu\n", n_in, ws_size); grid = -1; }
        if (grid < 0) fprintf(stderr, "kernel_launch: cannot launch (per_cu %d)\n", per_cu);
    }
    if (grid < 0) return;
    (void)hipMemsetAsync(d_ws, 0, 16384, stream);
    Args a{};
    for (int i = 0; i < 24; ++i) a.in[i] = (const float*)d_in[i];
    a.out = (float*)d_out; a.ws = (unsigned char*)d_ws; a.use_cg = 0; a.pad = 0;
    void* kargs[] = {&a};
    hipError_t e = hipLaunchCooperativeKernel((const void*)mk_fwd, dim3(grid), dim3(512), kargs, LDS_BYTES, stream);
    if (e != hipSuccess) fprintf(stderr, "cooperative launch failed: %s (grid %d)\n", hipGetErrorString(e), grid);
}
```
